# Optimizing an MI355X kernel written in HIP

```python
import math
import jax, jax.numpy as jnp
from jax import lax
import numpy as np

D_MODEL = 2048
BATCH = 4
SEQ = 4096
DEPTH = 1

CTX_LEN = 256
GRID_W = 64

HY_WIDTH = 1024
HY_ORDER = 2
HY_SHORT = 3
HY_BANDS = 16
HY_EMB_DIM = 1 + 2 * HY_BANDS
HY_FILTER_WIDTH = 64
HY_DECAY_TARGET = 1e-2
HY_DECAY_PCT_SLOW = 1.5
HY_DECAY_PCT_QUICK = 0.3

GDN_HEADS = 8
GDN_HEAD_DIM = 128
GDN_WIDTH = GDN_HEADS * GDN_HEAD_DIM
GDN_SHORT = 3
CHUNK = 64

D_FF = 5632
N_MOD = 9
EPS = 1e-6

HY_COLS = 3 * HY_WIDTH
Q_OFF = HY_COLS
KV_OFF = Q_OFF + GDN_WIDTH
Z_OFF = KV_OFF + 2 * GDN_WIDTH
AB_OFF = Z_OFF + GDN_WIDTH
GATE_OFF = AB_OFF + 4 * GDN_HEADS
IN_COLS = GATE_OFF + 2 * D_MODEL

kernel_name = "hyena_gdn_macaron_prefix_block"


def rms_norm(x, gain):
    xf = x.astype(jnp.float32)
    y = xf * lax.rsqrt(jnp.mean(xf * xf, -1, keepdims=True) + EPS)
    return (y * gain).astype(x.dtype)


def ada(xn, m, j):
    return xn * (1 + m[:, :, 3 * j + 1]) + m[:, :, 3 * j], m[:, :, 3 * j + 2]


def swiglu(x, w_gu, w_down):
    g, u = jnp.split(x @ w_gu, 2, -1)
    return (jax.nn.silu(g) * u) @ w_down


def ffn_half(h, m, j, gain, w_gu, w_down):
    xn, gate = ada(rms_norm(h, gain), m, j)
    return h + 0.5 * gate * swiglu(xn, w_gu, w_down)


def short_conv(x, w, rows):
    b_, L, C = x.shape
    K = w.shape[0]
    pad = K // 2
    n = L // rows
    xp = jnp.pad(x.reshape(b_, rows, n, C), ((0, 0), (0, 0), (pad, pad), (0, 0)))
    y = sum(xp[:, :, j:j + n] * w[j] for j in range(K))
    return y.reshape(b_, L, C)


def hyena_filters(L, w1, b1, w2, b2, w3, sin_freq):
    pos = jnp.arange(L, dtype=jnp.float32)
    t = (pos / L)[:, None]
    f = jnp.linspace(1e-4, HY_BANDS - 1, HY_BANDS, dtype=jnp.float32)
    ang = 2 * math.pi * t * f
    z = jnp.concatenate([t, jnp.cos(ang), -jnp.sin(ang)], -1)
    h = jnp.sin(sin_freq * (z @ w1 + b1))
    h = jnp.sin(sin_freq * (h @ w2 + b2))
    h = (h @ w3).reshape(L, HY_ORDER, 2, HY_WIDTH)
    deltas = jnp.abs(jnp.linspace(math.log(HY_DECAY_TARGET) / HY_DECAY_PCT_SLOW,
                                  math.log(HY_DECAY_TARGET) / HY_DECAY_PCT_QUICK,
                                  HY_WIDTH, dtype=jnp.float32))
    h = h * jnp.exp(-t[:, :, None, None] * deltas)
    return h / jnp.sum(jnp.abs(h), axis=(0, 2), keepdims=True)


def long_conv(z, h_fwd, h_bwd, bias):
    _, L, C = z.shape
    k = jnp.concatenate([h_fwd, jnp.zeros((1, C), h_fwd.dtype), h_bwd[:0:-1]], 0)
    zf = jnp.fft.rfft(z.astype(jnp.float32), n=2 * L, axis=1)
    kf = jnp.fft.rfft(k.astype(jnp.float32), n=2 * L, axis=0)
    y = jnp.fft.irfft(zf * kf, n=2 * L, axis=1)[:, :L]
    return (y + z * bias).astype(z.dtype)


def hyena_branch(v, x1, x2, filt, bias):
    z = v
    for o, gate in enumerate((x1, x2)):
        z = gate * long_conv(z, filt[:, o, 0], filt[:, o, 1], bias[o])
    return z


def split_heads(t):
    return t.reshape(*t.shape[:-1], GDN_HEADS, GDN_HEAD_DIM)


def l2norm(x):
    x = x.astype(jnp.float32)
    return x * lax.rsqrt(jnp.sum(x * x, -1, keepdims=True) + 1e-6)


def gdn_query(q_proj, conv_w, rows):
    q = jax.nn.silu(short_conv(q_proj, conv_w, rows))
    return l2norm(split_heads(q)) * (GDN_HEAD_DIM ** -0.5)


def gdn_keys_values(kv_proj, conv_w, rows):
    kv = jax.nn.silu(short_conv(kv_proj, conv_w, rows))
    k, v = jnp.split(kv, 2, -1)
    return l2norm(split_heads(k)), split_heads(v).astype(jnp.float32)


def gdn_decay_beta(ab_proj, a_log, dt_bias):
    ab = ab_proj.astype(jnp.float32).reshape(*ab_proj.shape[:-1], 2, 2, GDN_HEADS)
    g = -jnp.exp(a_log) * jax.nn.softplus(ab[..., 0, :, :] + dt_bias)
    beta = jax.nn.sigmoid(ab[..., 1, :, :])
    return g, beta


def gated_delta_chunked(k, v, g, beta, s0, q=None):
    b_, L, H, _ = k.shape
    n = L // CHUNK

    def chunks(t):
        t = t.astype(jnp.float32).reshape(b_, n, CHUNK, H, *t.shape[3:])
        return jnp.moveaxis(t, (1, 3), (0, 2))

    kc, vc, gc, bc = chunks(k), chunks(v), chunks(g), chunks(beta)
    gcum = jnp.cumsum(gc, -1)
    idx = jnp.arange(CHUNK)
    lower = idx[:, None] >= idx[None, :]
    decay = jnp.exp(jnp.where(lower, gcum[..., :, None] - gcum[..., None, :], -jnp.inf))
    kb = kc * bc[..., None]
    a = jnp.where(idx[:, None] > idx[None, :], jnp.einsum('nbhcd,nbhed->nbhce', kb, kc) * decay, 0.0)
    eye = jnp.eye(CHUNK, dtype=jnp.float32)
    t_inv = lax.linalg.triangular_solve(eye + a, jnp.broadcast_to(eye, a.shape),
                                        left_side=True, lower=True, unit_diagonal=True)
    u = t_inv @ (vc * bc[..., None])
    w = t_inv @ (kb * jnp.exp(gcum)[..., None])
    g_last = gcum[..., -1]
    k_dec = kc * jnp.exp(g_last[..., None] - gcum)[..., None]
    xs = (u, w, k_dec, g_last)
    if q is not None:
        qc = chunks(q)
        xs = xs + (qc * jnp.exp(gcum)[..., None], jnp.einsum('nbhcd,nbhed->nbhce', qc, kc) * decay)

    def step(S, inp):
        u_i, w_i, kd_i, gl_i = inp[:4]
        v_new = u_i - w_i @ S
        S_new = S * jnp.exp(gl_i)[..., None, None] + jnp.swapaxes(kd_i, -1, -2) @ v_new
        if q is None:
            return S_new, None
        qd_i, qk_i = inp[4:]
        return S_new, qd_i @ S + qk_i @ v_new

    s_fin, o = lax.scan(step, s0.astype(jnp.float32), xs)
    if q is None:
        return s_fin, None
    return s_fin, jnp.moveaxis(o, (0, 2), (1, 3)).reshape(b_, L, H, -1)


def gdn_bidir(k, v, g, beta, s0, q=None):
    rev = lambda t: None if t is None else jnp.flip(t, 1)
    s_f, o_f = gated_delta_chunked(k, v, g[:, :, 0], beta[:, :, 0], s0[0], q)
    s_b, o_b = gated_delta_chunked(rev(k), rev(v), rev(g[:, :, 1]), rev(beta[:, :, 1]), s0[1], rev(q))
    states = jnp.stack([s_f, s_b])
    return states, (None if q is None else o_f + rev(o_b))


def zero_states(b_):
    return jnp.zeros((2, b_, GDN_HEADS, GDN_HEAD_DIM, GDN_HEAD_DIM), jnp.float32)


def context_states(uc, lp):
    w, cw = lp['w_in'], lp['gdn_conv_w']
    k, v = gdn_keys_values(uc @ w[:, KV_OFF:Z_OFF], cw[:, GDN_WIDTH:], 1)
    g, beta = gdn_decay_beta(uc @ w[:, AB_OFF:GATE_OFF], lp['gdn_a_log'], lp['gdn_dt_bias'])
    states, _ = gdn_bidir(k, v, g, beta, zero_states(uc.shape[0]))
    return states


def token_mixer(u, rows, s0, lp):
    proj = u @ lp['w_in']
    hy = short_conv(proj[..., :HY_COLS], lp['hy_conv_w'], rows) + lp['hy_conv_b']
    hv, hx1, hx2 = jnp.split(hy, 3, -1)
    filt = hyena_filters(u.shape[1], lp['hy_f_w1'], lp['hy_f_b1'], lp['hy_f_w2'], lp['hy_f_b2'],
                         lp['hy_f_w3'], lp['hy_sin_freq'])
    y_hy = hyena_branch(hv, hx1, hx2, filt, lp['hy_bias']) @ lp['hy_out']
    cw = lp['gdn_conv_w']
    q = gdn_query(proj[..., Q_OFF:KV_OFF], cw[:, :GDN_WIDTH], rows)
    k, v = gdn_keys_values(proj[..., KV_OFF:Z_OFF], cw[:, GDN_WIDTH:], rows)
    g, beta = gdn_decay_beta(proj[..., AB_OFF:GATE_OFF], lp['gdn_a_log'], lp['gdn_dt_bias'])
    states, o = gdn_bidir(k, v, g, beta, s0, q)
    zg = split_heads(proj[..., Z_OFF:AB_OFF]).astype(jnp.float32)
    o = rms_norm(o, lp['gdn_norm_g']) * jax.nn.silu(zg)
    y_gdn = o.reshape(*u.shape[:2], GDN_WIDTH) @ lp['gdn_out']
    gates = jax.nn.sigmoid(proj[..., GATE_OFF:].astype(jnp.float32))
    merged = gates[..., :D_MODEL] * y_hy + gates[..., D_MODEL:] * y_gdn
    return merged @ lp['w_o'], states


def setup_inputs(seed: int = 0) -> dict:
    key = jax.random.key(seed)
    ks = iter(jax.random.split(key, 40))
    nrm = lambda shape, scale: jax.random.normal(next(ks), shape, jnp.float32) * scale
    H = GDN_HEADS
    dt = jnp.exp(jax.random.uniform(next(ks), (DEPTH, 2, H), jnp.float32,
                                    minval=math.log(1e-3), maxval=math.log(1e-1)))
    dt_bias = dt + jnp.log(-jnp.expm1(-dt))
    a_log = jnp.log(jax.random.uniform(next(ks), (DEPTH, 2, H), jnp.float32, minval=1.0, maxval=16.0))
    return {
        "x": nrm((BATCH, SEQ, D_MODEL), 1.0),
        "c": nrm((BATCH, D_MODEL), 1.0),
        "ctx": nrm((BATCH, CTX_LEN, D_MODEL), 1.0),
        "c_ctx": nrm((D_MODEL,), 1.0),
        "w_mod": nrm((DEPTH, D_MODEL, N_MOD * D_MODEL), 0.5 * D_MODEL ** -0.5),
        "b_mod": nrm((DEPTH, N_MOD * D_MODEL), 0.01),
        "norm_g": 1.0 + nrm((DEPTH, 3, D_MODEL), 0.02),
        "ffn1_wgu": nrm((DEPTH, D_MODEL, 2 * D_FF), D_MODEL ** -0.5),
        "ffn1_wd": nrm((DEPTH, D_FF, D_MODEL), D_FF ** -0.5),
        "ffn2_wgu": nrm((DEPTH, D_MODEL, 2 * D_FF), D_MODEL ** -0.5),
        "ffn2_wd": nrm((DEPTH, D_FF, D_MODEL), D_FF ** -0.5),
        "w_in": nrm((DEPTH, D_MODEL, IN_COLS), D_MODEL ** -0.5),
        "hy_conv_w": nrm((DEPTH, HY_SHORT, HY_COLS), HY_SHORT ** -0.5),
        "hy_conv_b": nrm((DEPTH, HY_COLS), 0.02),
        "hy_f_w1": nrm((DEPTH, HY_EMB_DIM, HY_FILTER_WIDTH), HY_EMB_DIM ** -0.5),
        "hy_f_b1": nrm((DEPTH, HY_FILTER_WIDTH), 0.1),
        "hy_f_w2": nrm((DEPTH, HY_FILTER_WIDTH, HY_FILTER_WIDTH), HY_FILTER_WIDTH ** -0.5),
        "hy_f_b2": nrm((DEPTH, HY_FILTER_WIDTH), 0.1),
        "hy_f_w3": nrm((DEPTH, HY_FILTER_WIDTH, HY_ORDER * 2 * HY_WIDTH), HY_FILTER_WIDTH ** -0.5),
        "hy_sin_freq": 1.0 + nrm((DEPTH, HY_FILTER_WIDTH), 0.1),
        "hy_bias": nrm((DEPTH, HY_ORDER, HY_WIDTH), 1.0),
        "hy_out": nrm((DEPTH, HY_WIDTH, D_MODEL), HY_WIDTH ** -0.5),
        "gdn_conv_w": nrm((DEPTH, GDN_SHORT, 3 * GDN_WIDTH), GDN_SHORT ** -0.5),
        "gdn_a_log": a_log,
        "gdn_dt_bias": dt_bias,
        "gdn_norm_g": 1.0 + nrm((DEPTH, GDN_HEAD_DIM), 0.02),
        "gdn_out": nrm((DEPTH, GDN_WIDTH, D_MODEL), GDN_WIDTH ** -0.5),
        "w_o": nrm((DEPTH, D_MODEL, D_MODEL), D_MODEL ** -0.5),
        "final_norm_g": 1.0 + nrm((D_MODEL,), 0.02),
    }


def reference(x, c, ctx, c_ctx, w_mod, b_mod, norm_g, ffn1_wgu, ffn1_wd, ffn2_wgu, ffn2_wd, w_in,
              hy_conv_w, hy_conv_b, hy_f_w1, hy_f_b1, hy_f_w2, hy_f_b2, hy_f_w3, hy_sin_freq, hy_bias,
              hy_out, gdn_conv_w, gdn_a_log, gdn_dt_bias, gdn_norm_g, gdn_out, w_o, final_norm_g):
    rows = x.shape[1] // GRID_W
    h, hc = x, ctx
    s_c = jax.nn.silu(c.astype(jnp.float32))
    s_cc = jax.nn.silu(c_ctx.astype(jnp.float32))
    for i in range(DEPTH):
        last = i == DEPTH - 1
        lp = {
            'w_in': w_in[i], 'hy_conv_w': hy_conv_w[i], 'hy_conv_b': hy_conv_b[i],
            'hy_f_w1': hy_f_w1[i], 'hy_f_b1': hy_f_b1[i], 'hy_f_w2': hy_f_w2[i], 'hy_f_b2': hy_f_b2[i],
            'hy_f_w3': hy_f_w3[i], 'hy_sin_freq': hy_sin_freq[i], 'hy_bias': hy_bias[i],
            'hy_out': hy_out[i], 'gdn_conv_w': gdn_conv_w[i], 'gdn_a_log': gdn_a_log[i],
            'gdn_dt_bias': gdn_dt_bias[i], 'gdn_norm_g': gdn_norm_g[i], 'gdn_out': gdn_out[i],
            'w_o': w_o[i],
        }
        mod = (s_c @ w_mod[i] + b_mod[i]).reshape(-1, 1, N_MOD, D_MODEL)
        mod_c = (s_cc @ w_mod[i] + b_mod[i]).reshape(1, 1, N_MOD, D_MODEL)
        h = ffn_half(h, mod, 0, norm_g[i, 0], ffn1_wgu[i], ffn1_wd[i])
        hc = ffn_half(hc, mod_c, 0, norm_g[i, 0], ffn1_wgu[i], ffn1_wd[i])
        uc, gate_c = ada(rms_norm(hc, norm_g[i, 1]), mod_c, 1)
        if last:
            s_ctx = context_states(uc, lp)
        else:
            y_c, s_ctx = token_mixer(uc, 1, zero_states(uc.shape[0]), lp)
            hc = hc + gate_c * y_c
        u, gate = ada(rms_norm(h, norm_g[i, 1]), mod, 1)
        y, _ = token_mixer(u, rows, s_ctx, lp)
        h = h + gate * y
        h = ffn_half(h, mod, 2, norm_g[i, 2], ffn2_wgu[i], ffn2_wd[i])
        if not last:
            hc = ffn_half(hc, mod_c, 2, norm_g[i, 2], ffn2_wgu[i], ffn2_wd[i])
    return rms_norm(h, final_norm_g)
```

```cpp
#include <hip/hip_runtime.h>
#include <hip/hip_cooperative_groups.h>
#include <cstdio>
#ifndef MK_MULTI
#define MK_MULTI 1
#endif
namespace pg8 {
#define PG8_LAS __attribute__((address_space(3)))
typedef unsigned short bf16_t;
typedef short bf16x8 __attribute__((ext_vector_type(8)));
typedef float f32x4 __attribute__((ext_vector_type(4)));
typedef unsigned u32x4 __attribute__((ext_vector_type(4)));
constexpr int BM = 256, BK = 64, HALF = 128, HTB = HALF * BK * 2  , STAGE_BYTES = 8 * HTB, NXCD = 8, WGM = 8;

__host__ __device__ __forceinline__ int lds_byte(int r, int c) { const int st = (r >> 4) * 2 + (c >> 5), rr = r & 15, cc = c & 31, ob = rr * 64 + cc * 2; return st * 1024 + (ob ^ (((ob >> 9) & 1) << 5)); }
__host__ __device__ __forceinline__ void stage_rc(int b, int& R, int& C) { const int st = b / 1024, sb = b % 1024, swz = sb ^ (((sb >> 9) & 1) << 5); R = (st >> 1) * 16 + swz / 64; C = (st & 1) * 32 + (swz % 64) / 2; }
__host__ __device__ __forceinline__ int perm32(int rho) { const int n = rho >> 4, i = rho & 15; return 8 * (i >> 2) + 4 * n + (i & 3); }

struct Unit { int pm, pn; };
struct Gemm { const bf16_t* A; const bf16_t* Bt; int M, N, K; };

struct StaticOrder {
    int nM, nN, nwg, G, c;
    __host__ __device__ void init(int M, int N, int G_, int c_) { nM = M / BM; nN = N / BM; nwg = nM * nN; G = G_; c = c_; }
    __host__ __device__ bool next(int i, Unit& u) const {
        const long L = (long)i * G + c; if (L >= nwg) return false;
        int wgid = (int)L; { const int q = nwg / NXCD, r = nwg % NXCD, xcd = wgid % NXCD, off = wgid / NXCD; wgid = (xcd < r ? xcd * (q + 1) : r * (q + 1) + (xcd - r) * q) + off; }
        const int nig = WGM * nN, gid = wgid / nig, fm = gid * WGM, gsz = (nM - fm) < WGM ? (nM - fm) : WGM;
        u.pm = fm + ((wgid % nig) % gsz); u.pn = (wgid % nig) / gsz; return true;
    }
    __device__ __forceinline__ void a_ready(const Unit&) const {}
    __device__ __forceinline__ void done(const Unit&) const {}
};
struct CountedOrder : StaticOrder {
    const unsigned* ready; unsigned need; unsigned* tmo;
    __device__ __forceinline__ void a_ready(const Unit& u) const {
        if (threadIdx.x < 64) {
            const unsigned long long t0 = __builtin_amdgcn_s_memrealtime(); unsigned polls = 0;
            while ((unsigned)__builtin_amdgcn_readfirstlane(__hip_atomic_load(ready + 64 * u.pm, __ATOMIC_RELAXED, __HIP_MEMORY_SCOPE_AGENT)) < need) {
                if ((++polls & 255u) == 0u && __builtin_amdgcn_readfirstlane(__hip_atomic_load(tmo, __ATOMIC_RELAXED, __HIP_MEMORY_SCOPE_AGENT)) != 0u) break;
                if (__builtin_amdgcn_s_memrealtime() - t0 > 2000000ull) {
                    if (threadIdx.x == 0) { unsigned expect = 0u; __hip_atomic_compare_exchange_strong(tmo + 1, &expect, 0x600u | (unsigned)(u.pm & 0xff), __ATOMIC_RELAXED, __ATOMIC_RELAXED, __HIP_MEMORY_SCOPE_AGENT); __hip_atomic_store(tmo, 1u, __ATOMIC_RELAXED, __HIP_MEMORY_SCOPE_AGENT); }
                    break; }
                __builtin_amdgcn_s_sleep(2); }
            __builtin_amdgcn_fence(__ATOMIC_ACQUIRE, "agent");
            asm volatile("s_waitcnt vmcnt(0)" ::: "memory");
        }
#if !defined(BROKEN_HOOK_NO_BARRIER)
        asm volatile("" ::: "memory"); __builtin_amdgcn_s_barrier(); asm volatile("" ::: "memory");
#endif
    }
};

__device__ __forceinline__ unsigned cvt_pk_bf16(float lo, float hi) { unsigned r; asm volatile("v_cvt_pk_bf16_f32 %0, %1, %2" : "=v"(r) : "v"(lo), "v"(hi)); return r; }
typedef float f32x2 __attribute__((ext_vector_type(2)));
__device__ __forceinline__ f32x2 gelu_pk(f32x2 v) {
    const f32x2 av = __builtin_elementwise_abs(v), d = av * 0.2316418882f + 1.0f;
    f32x2 t; t.x = __builtin_amdgcn_rcpf(d.x); t.y = __builtin_amdgcn_rcpf(d.y);
    f32x2 q = t * 0.5307027145f + (-0.7265760135f); q = q * t + 0.7107068705f; q = q * t + (-0.142248368f); q = q * t + 0.127414796f; q = q * t;
    const f32x2 s = (v * v) * (-0.72134752044f);
    f32x2 e; e.x = __builtin_amdgcn_exp2f(s.x); e.y = __builtin_amdgcn_exp2f(s.y);
    const f32x2 m = v * (q * e), r = v - m;
    f32x2 o; o.x = v.x < 0.f ? m.x : r.x; o.y = v.y < 0.f ? m.y : r.y; return o;
}

struct EpiF32 {
    static constexpr bool PERM = false, AFTER_DRAIN = false;
    float* C; int ldc; const float* bias;
    __device__ __forceinline__ void operator()(const f32x4 (&acc)[2][2][4][2], const Unit& u, int wr, int wc, int fr, int fq) const {
        const int row0 = u.pm * BM + wr * 64 + fr, col0 = u.pn * BM + wc * 32 + 4 * fq;
        f32x4 bv[2][2];
#pragma unroll
        for (int bj = 0; bj < 2; ++bj)
#pragma unroll
            for (int n = 0; n < 2; ++n) bv[bj][n] = bias ? *(const f32x4*)(bias + col0 + bj * HALF + n * 16) : (f32x4){0.f, 0.f, 0.f, 0.f};
#pragma unroll
        for (int ai = 0; ai < 2; ++ai)
#pragma unroll
            for (int m = 0; m < 4; ++m) { float* rowp = C + (size_t)(row0 + ai * HALF + m * 16) * ldc + col0;
#pragma unroll
                for (int bj = 0; bj < 2; ++bj)
#pragma unroll
                    for (int n = 0; n < 2; ++n) *(f32x4*)(rowp + bj * HALF + n * 16) = acc[ai][bj][m][n] + bv[bj][n]; }
    }
};
template <int ACT  > struct EpiBf16 {
    static constexpr bool PERM = true, AFTER_DRAIN = false;
    bf16_t* O; int ldc; const float* bias; int split_cols; size_t split_stride;
    __device__ __forceinline__ void operator()(const f32x4 (&acc)[2][2][4][2], const Unit& u, int wr, int wc, int fr, int fq) const {
        const int row0 = u.pm * BM + wr * 64 + fr; int colt = u.pn * BM; bf16_t* base = O;
        if (split_cols) { const int t = colt / split_cols; base += (size_t)t * split_stride; colt -= t * split_cols; }
        const int col0 = colt + wc * 32 + 8 * fq, bcol0 = u.pn * BM + wc * 32 + 8 * fq;
        f32x4 bv[2][2];
#pragma unroll
        for (int bj = 0; bj < 2; ++bj)
#pragma unroll
            for (int n = 0; n < 2; ++n) bv[bj][n] = bias ? *(const f32x4*)(bias + bcol0 + bj * HALF + 4 * n) : (f32x4){0.f, 0.f, 0.f, 0.f};
#pragma unroll
        for (int ai = 0; ai < 2; ++ai)
#pragma unroll
            for (int m = 0; m < 4; ++m) { bf16_t* rowp = base + (size_t)(row0 + ai * HALF + m * 16) * ldc + col0;
#pragma unroll
                for (int bj = 0; bj < 2; ++bj) { f32x4 v0 = acc[ai][bj][m][0] + bv[bj][0], v1 = acc[ai][bj][m][1] + bv[bj][1];
                    if (ACT == 1) { f32x2 a = gelu_pk((f32x2){v0[0], v0[1]}), b = gelu_pk((f32x2){v0[2], v0[3]}), c = gelu_pk((f32x2){v1[0], v1[1]}), d = gelu_pk((f32x2){v1[2], v1[3]});
                        v0 = (f32x4){a.x, a.y, b.x, b.y}; v1 = (f32x4){c.x, c.y, d.x, d.y}; }
                    if (ACT == 2) {
#pragma unroll
                        for (int j = 0; j < 4; ++j) { v0[j] = 0.5f * v0[j] * (1.0f + erff(v0[j] * 0.70710678f)); v1[j] = 0.5f * v1[j] * (1.0f + erff(v1[j] * 0.70710678f)); } }
                    u32x4 w; w.x = cvt_pk_bf16(v0[0], v0[1]); w.y = cvt_pk_bf16(v0[2], v0[3]); w.z = cvt_pk_bf16(v1[0], v1[1]); w.w = cvt_pk_bf16(v1[2], v1[3]);
                    *(u32x4*)(rowp + bj * HALF) = w; } }
    }
};

struct PanelStats {
    unsigned* xbuf;
    unsigned* cnt;
    unsigned* tmo;
    int ntn; float eps;
    unsigned code;
    __device__ __forceinline__ bool run(const f32x4 (&v)[2][2][4][2], const Unit& u, int wr, int wc, int fr, int fq, PG8_LAS unsigned char* lds, int wid, int lane) const {
        typedef float f32x2v __attribute__((ext_vector_type(2)));
        PG8_LAS f32x2v* P = (PG8_LAS f32x2v*)lds;
        PG8_LAS f32x2v* S = (PG8_LAS f32x2v*)(lds + 8192);
        PG8_LAS unsigned* flag = (PG8_LAS unsigned*)(lds + 8192 + 2048);
#pragma unroll
        for (int ai = 0; ai < 2; ++ai)
#pragma unroll
            for (int m = 0; m < 4; ++m) {
                float s = 0.f;
#pragma unroll
                for (int bj = 0; bj < 2; ++bj)
#pragma unroll
                    for (int n = 0; n < 2; ++n) { const f32x4 x = v[ai][bj][m][n]; s += (x[0] + x[1]) + (x[2] + x[3]); }
                s += __shfl_xor(s, 16); s += __shfl_xor(s, 32);
                const float mw = s * (1.0f / 64.0f); float q = 0.f;
#pragma unroll
                for (int bj = 0; bj < 2; ++bj)
#pragma unroll
                    for (int n = 0; n < 2; ++n) { const f32x4 d = v[ai][bj][m][n] - mw; q += (d[0] * d[0] + d[1] * d[1]) + (d[2] * d[2] + d[3] * d[3]); }
                q += __shfl_xor(q, 16); q += __shfl_xor(q, 32);
                if (fq == 0) P[(ai * HALF + wr * 64 + m * 16 + fr) * 4 + wc] = (f32x2v){mw, q};
            }
        asm volatile("s_waitcnt lgkmcnt(0)" ::: "memory"); __builtin_amdgcn_s_barrier(); asm volatile("" ::: "memory");
#if defined(BROKEN_NO_WAIT)
        if (blockIdx.x >= 64) { const long long t0 = clock64(); while (clock64() - t0 < 60000) __builtin_amdgcn_s_sleep(8); }
#endif
        const int row = wid * 32 + (lane & 31);
        if (lane < 32) {
            const f32x2v a = P[row * 4 + 0], b = P[row * 4 + 1], c = P[row * 4 + 2], d = P[row * 4 + 3];
            const float mt = (a.x + b.x + c.x + d.x) * 0.25f;
            const float da = a.x - mt, db = b.x - mt, dc = c.x - mt, dd = d.x - mt;
            const float m2 = (a.y + b.y) + (c.y + d.y) + 64.0f * ((da * da + db * db) + (dc * dc + dd * dd));
            unsigned long long* slot = (unsigned long long*)xbuf + ((size_t)(u.pm * BM + row) * 4 + u.pn);
            __hip_atomic_store(slot, ((unsigned long long)__float_as_uint(m2) << 32) | __float_as_uint(mt), __ATOMIC_RELAXED, __HIP_MEMORY_SCOPE_AGENT);
        }
        asm volatile("s_waitcnt vmcnt(0)" ::: "memory");
        if (lane == 0) __hip_atomic_fetch_add(cnt + 64 * u.pm, 1u, __ATOMIC_RELAXED, __HIP_MEMORY_SCOPE_AGENT);
        if (wid == 0) {
            bool dead = false; const unsigned long long t0 = __builtin_amdgcn_s_memrealtime(); const unsigned want = 8u * (unsigned)ntn;
            for (;;) {
#if defined(BROKEN_NO_WAIT)
                break;
#endif
                if ((unsigned)__builtin_amdgcn_readfirstlane(__hip_atomic_load(cnt + 64 * u.pm, __ATOMIC_RELAXED, __HIP_MEMORY_SCOPE_AGENT)) >= want) break;
                if (__builtin_amdgcn_s_memrealtime() - t0 > 2000000ull) {
                    if (lane == 0) { unsigned expect = 0u; __hip_atomic_compare_exchange_strong(tmo + 1, &expect, code | (unsigned)(u.pm & 0xff), __ATOMIC_RELAXED, __ATOMIC_RELAXED, __HIP_MEMORY_SCOPE_AGENT);
                                     __hip_atomic_store(tmo, 1u, __ATOMIC_RELAXED, __HIP_MEMORY_SCOPE_AGENT); }
                    dead = true; break; }
                __builtin_amdgcn_s_sleep(2);
            }
            __builtin_amdgcn_fence(__ATOMIC_ACQUIRE, "agent");
            if (lane == 0) flag[0] = dead ? 1u : 0u;
        }
        asm volatile("s_waitcnt vmcnt(0) lgkmcnt(0)" ::: "memory"); __builtin_amdgcn_s_barrier(); asm volatile("" ::: "memory");
        const bool bad = flag[0] != 0u;
        if (lane < 32) {
            const unsigned long long* slot = (const unsigned long long*)xbuf + (size_t)(u.pm * BM + row) * 4; float mt[4], m2[4]; float ms = 0.f;
#pragma unroll
            for (int t = 0; t < 4; ++t) { if (t < ntn) { const unsigned long long w = __hip_atomic_load(slot + t, __ATOMIC_RELAXED, __HIP_MEMORY_SCOPE_AGENT); mt[t] = __uint_as_float((unsigned)w); m2[t] = __uint_as_float((unsigned)(w >> 32)); } else { mt[t] = 0.f; m2[t] = 0.f; } ms += mt[t]; }
            const float mean = ms / (float)ntn; float q = 0.f;
#pragma unroll
            for (int t = 0; t < 4; ++t) if (t < ntn) { const float dm = mt[t] - mean; q += m2[t] + 256.0f * dm * dm; }
            S[row] = (f32x2v){mean, 1.0f / sqrtf(q / (256.0f * (float)ntn) + eps)};
        }
        asm volatile("s_waitcnt lgkmcnt(0)" ::: "memory"); __builtin_amdgcn_s_barrier(); asm volatile("" ::: "memory");
        return bad;
    }
};
struct EpiLnRes {
    static constexpr bool PERM = false, AFTER_DRAIN = true;
    const float* base; float* out; int ldc; const float* bias; PanelStats st; unsigned poison;
    __device__ __forceinline__ void refuse(size_t i0, size_t stride, int M, int N) const { const float q = __builtin_nanf(""); for (size_t i = i0; i < (size_t)M * N; i += stride) out[(i / N) * ldc + i % N] = q;
        if (i0 == 0) { unsigned expect = 0u; __hip_atomic_compare_exchange_strong(st.tmo + 1, &expect, 0x7f0u, __ATOMIC_RELAXED, __ATOMIC_RELAXED, __HIP_MEMORY_SCOPE_AGENT); __hip_atomic_store(st.tmo, 1u, __ATOMIC_RELAXED, __HIP_MEMORY_SCOPE_AGENT); } }
    __device__ __forceinline__ void fused(f32x4 (&acc)[2][2][4][2], const Unit& u, int wr, int wc, int fr, int fq, PG8_LAS unsigned char* lds, int wid, int lane) const {
        typedef float f32x2v __attribute__((ext_vector_type(2)));
        const PG8_LAS f32x2v* S = (const PG8_LAS f32x2v*)(lds + 8192);
        const int col0 = u.pn * BM + wc * 32 + 4 * fq;
#pragma unroll
        for (int bj = 0; bj < 2; ++bj)
#pragma unroll
            for (int n = 0; n < 2; ++n) { const f32x4 bv = bias ? *(const f32x4*)(bias + col0 + bj * HALF + n * 16) : (f32x4){0.f, 0.f, 0.f, 0.f};
#pragma unroll
                for (int ai = 0; ai < 2; ++ai)
#pragma unroll
                    for (int m = 0; m < 4; ++m) acc[ai][bj][m][n] += bv; }
        const bool bad = st.run(acc, u, wr, wc, fr, fq, lds, wid, lane) || poison != 0u;
        const float qnan = __builtin_nanf("");
#pragma unroll
        for (int ai = 0; ai < 2; ++ai)
#pragma unroll
            for (int m = 0; m < 4; ++m) { const int r = ai * HALF + wr * 64 + m * 16 + fr; const f32x2v sr = S[r]; const size_t off = (size_t)(u.pm * BM + r) * ldc + col0;
#pragma unroll
                for (int bj = 0; bj < 2; ++bj)
#pragma unroll
                    for (int n = 0; n < 2; ++n) { const f32x4 bs = *(const f32x4*)(base + off + bj * HALF + n * 16); f32x4 o = bs + (acc[ai][bj][m][n] - sr.x) * sr.y;
                        if (bad) o = (f32x4){qnan, qnan, qnan, qnan}; *(f32x4*)(out + off + bj * HALF + n * 16) = o; }
                asm volatile("" ::: "memory"); }
    }
};
struct EpiLnResLn {
    static constexpr bool PERM = false, AFTER_DRAIN = true;
    const float* base; float* out; bf16_t* xn; int ldc; const float* bias; PanelStats st1, st2; unsigned poison;
    __device__ __forceinline__ void refuse(size_t i0, size_t stride, int M, int N) const { const float q = __builtin_nanf(""); for (size_t i = i0; i < (size_t)M * N; i += stride) { const size_t o = (i / N) * ldc + i % N; out[o] = q; xn[o] = (bf16_t)0x7fc0u; }
        if (i0 == 0) { unsigned expect = 0u; __hip_atomic_compare_exchange_strong(st1.tmo + 1, &expect, 0x7f0u, __ATOMIC_RELAXED, __ATOMIC_RELAXED, __HIP_MEMORY_SCOPE_AGENT); __hip_atomic_store(st1.tmo, 1u, __ATOMIC_RELAXED, __HIP_MEMORY_SCOPE_AGENT); } }
    __device__ __forceinline__ void fused(f32x4 (&acc)[2][2][4][2], const Unit& u, int wr, int wc, int fr, int fq, PG8_LAS unsigned char* lds, int wid, int lane) const {
        typedef float f32x2v __attribute__((ext_vector_type(2))); typedef unsigned u32x2v __attribute__((ext_vector_type(2)));
        const PG8_LAS f32x2v* S = (const PG8_LAS f32x2v*)(lds + 8192);
        const int col0 = u.pn * BM + wc * 32 + 4 * fq;
#pragma unroll
        for (int bj = 0; bj < 2; ++bj)
#pragma unroll
            for (int n = 0; n < 2; ++n) { const f32x4 bv = bias ? *(const f32x4*)(bias + col0 + bj * HALF + n * 16) : (f32x4){0.f, 0.f, 0.f, 0.f};
#pragma unroll
                for (int ai = 0; ai < 2; ++ai)
#pragma unroll
                    for (int m = 0; m < 4; ++m) acc[ai][bj][m][n] += bv; }
        bool bad = st1.run(acc, u, wr, wc, fr, fq, lds, wid, lane) || poison != 0u;
        const float qnan = __builtin_nanf("");
#pragma unroll
        for (int ai = 0; ai < 2; ++ai)
#pragma unroll
            for (int m = 0; m < 4; ++m) { const int r = ai * HALF + wr * 64 + m * 16 + fr; const f32x2v sr = S[r]; const size_t off = (size_t)(u.pm * BM + r) * ldc + col0;
#pragma unroll
                for (int bj = 0; bj < 2; ++bj)
#pragma unroll
                    for (int n = 0; n < 2; ++n) { const f32x4 bs = *(const f32x4*)(base + off + bj * HALF + n * 16); acc[ai][bj][m][n] = bs + (acc[ai][bj][m][n] - sr.x) * sr.y; }
                asm volatile("" : "+v"(acc[ai][0][m][0]), "+v"(acc[ai][0][m][1]), "+v"(acc[ai][1][m][0]), "+v"(acc[ai][1][m][1]));
                if (m & 1) asm volatile("" ::: "memory"); }
        const bool bad1 = bad;
        bad = st2.run(acc, u, wr, wc, fr, fq, lds, wid, lane) || bad;
#pragma unroll
        for (int ai = 0; ai < 2; ++ai)
#pragma unroll
            for (int m = 0; m < 4; ++m) { const int r = ai * HALF + wr * 64 + m * 16 + fr; const f32x2v sr = S[r]; const size_t off = (size_t)(u.pm * BM + r) * ldc + col0;
#pragma unroll
                for (int bj = 0; bj < 2; ++bj)
#pragma unroll
                    for (int n = 0; n < 2; ++n) { const f32x4 x1 = acc[ai][bj][m][n]; *(f32x4*)(out + off + bj * HALF + n * 16) = bad1 ? (f32x4){qnan, qnan, qnan, qnan} : x1;
                        const f32x4 o = (x1 - sr.x) * sr.y; u32x2v w; w.x = cvt_pk_bf16(o[0], o[1]); w.y = cvt_pk_bf16(o[2], o[3]);
                        if (bad) { w.x = 0x7fc07fc0u; w.y = 0x7fc07fc0u; } *(u32x2v*)(xn + off + bj * HALF + n * 16) = w; }
                asm volatile("" ::: "memory"); }
    }
};

template <class Epi, class Sched, bool STAMP = false>
__device__ __forceinline__ void gemm_phase(PG8_LAS unsigned char* lds, const Gemm g, const Sched& S, const Epi& E, unsigned long long* stamps) {
    const int tid = threadIdx.x, wid = __builtin_amdgcn_readfirstlane(tid >> 6), lane = tid & 63, wr = wid >> 2, wc = wid & 3, fr = lane & 15, fq = lane >> 4;
    const int K = g.K, nt = K / BK;
    int ts_lo = 0, ts_hi = 0, nts = 0; const unsigned long long rt_entry = STAMP ? (unsigned long long)wall_clock64() : 0ull;
#define PG8_STAMP() do { if (STAMP && wid == 0 && nts < 64) { const unsigned long long _c = (unsigned long long)clock64(); \
        ts_lo = (lane == nts) ? (int)(unsigned)_c : ts_lo; ts_hi = (lane == nts) ? (int)(unsigned)(_c >> 32) : ts_hi; ++nts; } } while (0)
    PG8_STAMP();
    unsigned voffA[2], voffB[2];
#pragma unroll
    for (int i = 0; i < 2; ++i) { int R, C; stage_rc(tid * 16 + i * 8192, R, C); const int Rb = Epi::PERM ? ((R & ~31) + perm32(R & 31)) : R;
        voffA[i] = (unsigned)(R * K + C) * 2u; voffB[i] = (unsigned)(Rb * K + C) * 2u; }
    const size_t kstep = (size_t)(BK * 2);
    const size_t hstep = (size_t)HALF * K * 2;
    const size_t tstep = 2 * hstep;
    const unsigned ldsw = (unsigned)wid * 1024u;
    const int aoff = lds_byte(wr * 64 + fr, fq * 8), boff = lds_byte(wc * 32 + fr, fq * 8);
#define PG8_SA(b, h) (((b) * 2 + (h)) * HTB)
#define PG8_SB(b, h) ((4 + (b) * 2 + (h)) * HTB)
#define PG8_STAGE(bufoff, gbase, voff) do { _Pragma("unroll") for (int _i = 0; _i < 2; ++_i) \
        __builtin_amdgcn_global_load_lds((const unsigned*)((const char*)(gbase) + (voff)[_i]), (PG8_LAS unsigned*)(lds + (bufoff) + ldsw + _i * 8192), 16, 0, 0); } while (0)
#define PG8_LDA(dst, b, h) do { _Pragma("unroll") for (int m = 0; m < 4; ++m) _Pragma("unroll") for (int k = 0; k < 2; ++k) dst[m][k] = *(const PG8_LAS bf16x8*)(lds + PG8_SA(b, h) + aoff + m * 2048 + k * 1024); } while (0)
#define PG8_LDB(dst, b, h) do { _Pragma("unroll") for (int n = 0; n < 2; ++n) _Pragma("unroll") for (int k = 0; k < 2; ++k) dst[n][k] = *(const PG8_LAS bf16x8*)(lds + PG8_SB(b, h) + boff + n * 2048 + k * 1024); } while (0)
#define PG8_MMA(ai, bj, At, Bt) do { __builtin_amdgcn_s_setprio(1); _Pragma("unroll") for (int m = 0; m < 4; ++m) _Pragma("unroll") for (int n = 0; n < 2; ++n) _Pragma("unroll") for (int k = 0; k < 2; ++k) \
        acc[ai][bj][m][n] = __builtin_amdgcn_mfma_f32_16x16x32_bf16(Bt[n][k], At[m][k], acc[ai][bj][m][n], 0, 0, 0); __builtin_amdgcn_s_setprio(0); } while (0)
#define PG8_WAIT_V(n) asm volatile("s_waitcnt vmcnt(" #n ")" ::: "memory")
#define PG8_WAIT_L(n) asm volatile("s_waitcnt lgkmcnt(" #n ")" ::: "memory")
#define PG8_BAR __builtin_amdgcn_s_barrier()
#define PG8_SCHED __builtin_amdgcn_sched_barrier(0)
    Unit cur, nxt; int ui = 0;
    if (!S.next(0, cur)) return;
    f32x4 acc[2][2][4][2];
#pragma unroll
    for (int a = 0; a < 2; ++a)
#pragma unroll
        for (int b = 0; b < 2; ++b)
#pragma unroll
            for (int m = 0; m < 4; ++m)
#pragma unroll
                for (int n = 0; n < 2; ++n) acc[a][b][m][n] = (f32x4){0.f, 0.f, 0.f, 0.f};
    bf16x8 At[4][2], B0[2][2], B1[2][2];
    const char* cA = (const char*)g.A + (size_t)cur.pm * tstep; const char* cB = (const char*)g.Bt + (size_t)cur.pn * tstep;
    S.a_ready(cur);
    PG8_STAGE(PG8_SB(0, 0), cB, voffB); PG8_STAGE(PG8_SA(0, 0), cA, voffA); PG8_STAGE(PG8_SB(0, 1), cB + hstep, voffB); PG8_STAGE(PG8_SA(0, 1), cA + hstep, voffA);
    if (wr == 1) PG8_BAR;
    PG8_WAIT_V(4); PG8_BAR;
    PG8_STAGE(PG8_SB(1, 0), cB + kstep, voffB); PG8_STAGE(PG8_SA(1, 0), cA + kstep, voffA); PG8_STAGE(PG8_SB(1, 1), cB + hstep + kstep, voffB);
    PG8_WAIT_V(6); PG8_BAR;
    PG8_STAMP();
    for (;;) {
        const bool has_next = S.next(ui + 1, nxt);
        const char* nA = has_next ? (const char*)g.A + (size_t)nxt.pm * tstep : cA; const char* nB = has_next ? (const char*)g.Bt + (size_t)nxt.pn * tstep : cB;
        for (int t = 0; t < nt; t += 2) {
            const bool last = (t == nt - 2);
            const char* a1 = cA + (size_t)(t + 1) * kstep;
            const char* a2 = last ? nA : cA + (size_t)(t + 2) * kstep; const char* b2 = last ? nB : cB + (size_t)(t + 2) * kstep;
            const char* a3 = a2 + kstep; const char* b3 = b2 + kstep;
            if (last && has_next) S.a_ready(nxt);
            PG8_LDB(B0, 0, 0); PG8_SCHED; PG8_LDA(At, 0, 0); PG8_STAGE(PG8_SA(1, 1), a1 + hstep, voffA);
            PG8_WAIT_L(8); PG8_BAR; PG8_WAIT_L(0); PG8_MMA(0, 0, At, B0); PG8_BAR; PG8_SCHED;
            PG8_LDB(B1, 0, 1); PG8_STAGE(PG8_SB(0, 0), b2, voffB);
            PG8_BAR; PG8_WAIT_L(0); PG8_MMA(0, 1, At, B1); PG8_BAR;
            PG8_LDA(At, 0, 1); PG8_STAGE(PG8_SA(0, 0), a2, voffA);
            PG8_BAR; PG8_WAIT_L(0); PG8_MMA(1, 0, At, B0); PG8_BAR; PG8_SCHED;
            PG8_STAGE(PG8_SB(0, 1), b2 + hstep, voffB);
            PG8_WAIT_V(6); PG8_BAR; PG8_MMA(1, 1, At, B1); PG8_BAR;
            PG8_LDB(B0, 1, 0); PG8_SCHED; PG8_LDA(At, 1, 0); PG8_STAGE(PG8_SA(0, 1), a2 + hstep, voffA);
            PG8_WAIT_L(8); PG8_BAR; PG8_WAIT_L(0); PG8_MMA(0, 0, At, B0); PG8_BAR; PG8_SCHED;
            PG8_LDB(B1, 1, 1); PG8_STAGE(PG8_SB(1, 0), b3, voffB);
            PG8_BAR; PG8_WAIT_L(0); PG8_MMA(0, 1, At, B1); PG8_BAR;
            PG8_LDA(At, 1, 1); PG8_STAGE(PG8_SA(1, 0), a3, voffA);
            PG8_BAR; PG8_WAIT_L(0); PG8_MMA(1, 0, At, B0); PG8_BAR; PG8_SCHED;
            PG8_STAGE(PG8_SB(1, 1), b3 + hstep, voffB);
            PG8_WAIT_V(6); PG8_BAR; PG8_MMA(1, 1, At, B1); PG8_BAR;
        }
        PG8_STAMP();
        if constexpr (!Epi::AFTER_DRAIN) { E(acc, cur, wr, wc, fr, fq); S.done(cur); }
        PG8_STAMP();
        if (!has_next) break;
#pragma unroll
        for (int a = 0; a < 2; ++a)
#pragma unroll
            for (int b = 0; b < 2; ++b)
#pragma unroll
                for (int m = 0; m < 4; ++m)
#pragma unroll
                    for (int n = 0; n < 2; ++n) acc[a][b][m][n] = (f32x4){0.f, 0.f, 0.f, 0.f};
        cur = nxt; cA = nA; cB = nB; ++ui;
    }
    PG8_WAIT_V(0);
    if (wr == 0) PG8_BAR;
    PG8_BAR;
    if constexpr (Epi::AFTER_DRAIN) { E.fused(acc, cur, wr, wc, fr, fq, lds, wid, lane); S.done(cur); }
    PG8_STAMP();
    if (STAMP && wid == 0) { stamps[lane] = lane < nts ? (((unsigned long long)(unsigned)ts_hi << 32) | (unsigned)ts_lo) : 0ull;
        if (lane == 62) stamps[62] = rt_entry; if (lane == 63) stamps[63] = (unsigned long long)wall_clock64(); }
#undef PG8_STAMP
#undef PG8_SA
#undef PG8_SB
#undef PG8_STAGE
#undef PG8_LDA
#undef PG8_LDB
#undef PG8_MMA
#undef PG8_WAIT_V
#undef PG8_WAIT_L
#undef PG8_BAR
#undef PG8_SCHED
}
}

namespace cg = cooperative_groups;
namespace mk {
using pg8::bf16_t; using pg8::f32x4; using pg8::u32x4; using pg8::Unit;
typedef unsigned u32x2 __attribute__((ext_vector_type(2)));
typedef float f32x2 __attribute__((ext_vector_type(2)));
#define LDS_WAIT() asm volatile("s_waitcnt lgkmcnt(0)" ::: "memory")

constexpr int D = 2048, FF = 5632, ML = 16384, MC = 1024, MT = 17408, SEQ = 4096, CTXL = 256;
constexpr int NIN = 11520, NMOD = 18432;
constexpr int NITEM = 4352;

constexpr size_t al(size_t x) { return (x + 255) & ~(size_t)255; }
constexpr size_t OFF_MOD  = 0;
constexpr size_t OFF_H2   = al(OFF_MOD + (size_t)5 * NMOD * 4);
constexpr size_t OFF_HC   = al(OFF_H2 + (size_t)4096 * 64 * 4);
constexpr size_t OFF_ABF  = al(OFF_HC + (size_t)MC * D * 4);
constexpr size_t OFF_G    = al(OFF_ABF + (size_t)MT * 32 * 4);
constexpr size_t OFF_BETA = al(OFF_G + (size_t)MT * 16 * 4);
constexpr size_t OFF_XN   = al(OFF_BETA + (size_t)MT * 16 * 4);
constexpr size_t OFF_WA   = al(OFF_XN + (size_t)MT * D * 2);
constexpr size_t OFF_WA_D = OFF_WA + (size_t)2 * FF * D * 2;
constexpr size_t OFF_WB   = al(OFF_WA_D + (size_t)D * FF * 2);
constexpr size_t OFF_BIG  = al(OFF_WB + (size_t)NIN * D * 2);
constexpr size_t SZ_PH    = (size_t)ML * 3072 * 2;
constexpr size_t SZ_PQKV  = (size_t)MT * 3072 * 2;
constexpr size_t OFF_PH   = OFF_BIG;
constexpr size_t OFF_PQKV = OFF_BIG + SZ_PH;
constexpr size_t OFF_PB   = al(OFF_PQKV + SZ_PQKV);
constexpr size_t OFF_O    = al(OFF_PB + (size_t)ML * 5120 * 2);
constexpr size_t WS_END   = al(OFF_O + (size_t)2 * ML * 1024 * 2);
constexpr size_t OFF_ACT  = OFF_BIG;
constexpr size_t OFF_U    = OFF_XN;
constexpr size_t OFF_W    = OFF_U + (size_t)NITEM * 64 * 128 * 2;
constexpr size_t OFF_QK   = OFF_W + (size_t)NITEM * 64 * 128 * 2;
constexpr size_t OFF_GC   = OFF_QK + (size_t)NITEM * 64 * 64 * 2;
constexpr size_t OFF_KFS  = OFF_XN;
constexpr size_t OFF_HYT  = OFF_PQKV;
constexpr size_t OFF_Z2   = OFF_BIG;
constexpr size_t OFF_TMP  = OFF_BIG + (size_t)ML * 1024 * 2;
constexpr size_t OFF_WHY  = OFF_WB;
constexpr size_t OFF_WGD  = OFF_WHY + (size_t)D * 1024 * 2;
constexpr size_t OFF_WO   = OFF_WGD + (size_t)D * 1024 * 2;
static_assert(OFF_GC + (size_t)NITEM * 64 * 4 <= OFF_BIG, "UWQK overflow");
static_assert(OFF_KFS + (size_t)2 * 1024 * 8192 * 8 <= OFF_WB, "KFS overflow");
static_assert((size_t)MT * FF * 2 <= OFF_PB - OFF_BIG, "ACT overflow");
static_assert(OFF_TMP + (size_t)ML * D * 4 <= OFF_PB, "TMP overflow");
static_assert(OFF_WO + (size_t)D * D * 2 <= OFF_BIG, "WB overflow");

constexpr int LDS_BYTES = 147456;

struct Args { const float* in[29]; float* out; unsigned char* ws; int ph_lo, ph_hi; };

__device__ __forceinline__ float wave_sum(float v) {
#pragma unroll
    for (int o = 1; o < 64; o <<= 1) v += __shfl_xor(v, o);
    return v;
}
__device__ __forceinline__ float bf2f(unsigned short b) { return __uint_as_float((unsigned)b << 16); }
__device__ __forceinline__ float bflo(unsigned w) { return __uint_as_float(w << 16); }
__device__ __forceinline__ float bfhi(unsigned w) { return __uint_as_float(w & 0xffff0000u); }
__device__ __forceinline__ unsigned pk2(float lo, float hi) { return pg8::cvt_pk_bf16(lo, hi); }
__device__ __forceinline__ float silu_f(float x) { return x / (1.f + __expf(-x)); }
__device__ __forceinline__ float sigm_f(float x) { return 1.f / (1.f + __expf(-x)); }

__device__ __forceinline__ void conv_item(const float* __restrict__ W, int K, int Nsrc, bf16_t* __restrict__ WT, int kb, int n0dst, int n0src, float* scr, int lane) {
    const int k0 = 64 * kb;
#pragma unroll 8
    for (int i = 0; i < 32; ++i) { const int kk = 2 * i + (lane >> 5); float v = 0.f; if (n0src >= 0) v = W[(size_t)(k0 + kk) * Nsrc + n0src + (lane & 31)]; scr[kk * 33 + (lane & 31)] = v; }
    LDS_WAIT();
    const int c = lane & 7;
#pragma unroll
    for (int j = 0; j < 4; ++j) { const int n = (lane >> 3) + 8 * j; const float* s = scr + (8 * c) * 33 + n;
        u32x4 o; o.x = pk2(s[0], s[33]); o.y = pk2(s[66], s[99]); o.z = pk2(s[132], s[165]); o.w = pk2(s[198], s[231]);
        *(u32x4*)(WT + (size_t)(n0dst + n) * K + k0 + 8 * c) = o; }
    LDS_WAIT();
}
__device__ __forceinline__ int colmap(int mode, int n0) {
    if (mode == 0) return n0;
    if (mode == 1) { const int pn = n0 >> 8, half = (n0 >> 7) & 1; return half * FF + pn * 128 + (n0 & 127); }
    if (n0 <= 7168) return n0;
    if (n0 < 7424) return -1;
    return 7200 + (n0 - 7424);
}
__device__ __forceinline__ void conv_matrix(const float* W, int K, int Nsrc, bf16_t* WT, int Ndst, int mode, int it, float* scr, int lane) {
    const int nblk = Ndst / 32, kb = it / nblk, nb = it % nblk;
    conv_item(W, K, Nsrc, WT, kb, nb * 32, colmap(mode, nb * 32), scr, lane);
}

__device__ __forceinline__ void norm_ada_row(const float* __restrict__ src, const float* __restrict__ gain, const float* __restrict__ shift, const float* __restrict__ scale, bf16_t* __restrict__ dst, int lane) {
    f32x4 v[8]; float ss = 0.f;
#pragma unroll
    for (int j = 0; j < 8; ++j) { v[j] = *(const f32x4*)(src + 4 * lane + 256 * j); ss += (v[j].x * v[j].x + v[j].y * v[j].y) + (v[j].z * v[j].z + v[j].w * v[j].w); }
    ss = wave_sum(ss);
    const float rstd = rsqrtf(ss * (1.f / 2048.f) + 1e-6f);
#pragma unroll
    for (int j = 0; j < 8; ++j) {
        const f32x4 g = *(const f32x4*)(gain + 4 * lane + 256 * j), sh = *(const f32x4*)(shift + 4 * lane + 256 * j), sc = *(const f32x4*)(scale + 4 * lane + 256 * j);
        const f32x4 y = (v[j] * rstd) * g; const f32x4 o = y * (sc + 1.f) + sh;
        u32x2 w; w.x = pk2(o.x, o.y); w.y = pk2(o.z, o.w);
        *(u32x2*)(dst + 4 * lane + 256 * j) = w; }
}
__device__ __forceinline__ void final_norm_row(float* __restrict__ row, const float* __restrict__ gain, int lane) {
    f32x4 v[8]; float ss = 0.f;
#pragma unroll
    for (int j = 0; j < 8; ++j) { v[j] = *(const f32x4*)(row + 4 * lane + 256 * j); ss += (v[j].x * v[j].x + v[j].y * v[j].y) + (v[j].z * v[j].z + v[j].w * v[j].w); }
    ss = wave_sum(ss);
    const float rstd = rsqrtf(ss * (1.f / 2048.f) + 1e-6f);
#pragma unroll
    for (int j = 0; j < 8; ++j) { const f32x4 g = *(const f32x4*)(gain + 4 * lane + 256 * j); *(f32x4*)(row + 4 * lane + 256 * j) = (v[j] * rstd) * g; }
}

struct EpiSwiglu {
    static constexpr bool PERM = true, AFTER_DRAIN = false;
    bf16_t* O; int ldc;
    __device__ __forceinline__ void operator()(const f32x4 (&acc)[2][2][4][2], const Unit& u, int wr, int wc, int fr, int fq) const {
        const int row0 = u.pm * 256 + wr * 64 + fr, col0 = u.pn * 128 + wc * 32 + 8 * fq;
#pragma unroll
        for (int ai = 0; ai < 2; ++ai)
#pragma unroll
            for (int m = 0; m < 4; ++m) {
                const f32x4 g0 = acc[ai][0][m][0], g1 = acc[ai][0][m][1], u0 = acc[ai][1][m][0], u1 = acc[ai][1][m][1];
                u32x4 w;
                w.x = pk2(silu_f(g0[0]) * u0[0], silu_f(g0[1]) * u0[1]); w.y = pk2(silu_f(g0[2]) * u0[2], silu_f(g0[3]) * u0[3]);
                w.z = pk2(silu_f(g1[0]) * u1[0], silu_f(g1[1]) * u1[1]); w.w = pk2(silu_f(g1[2]) * u1[2], silu_f(g1[3]) * u1[3]);
                *(u32x4*)(O + (size_t)(row0 + ai * 128 + m * 16) * ldc + col0) = w; }
    }
};
struct EpiResid {
    static constexpr bool PERM = false, AFTER_DRAIN = false;
    const float* inL; const float* inC; float* outL; float* outC; const float* gate0; float s;
    __device__ __forceinline__ void operator()(const f32x4 (&acc)[2][2][4][2], const Unit& u, int wr, int wc, int fr, int fq) const {
        const bool lat = u.pm < 64; const int bm = lat ? (u.pm >> 4) : 4; const int rb = lat ? u.pm * 256 : (u.pm - 64) * 256;
        const float* in = lat ? inL : inC; float* out = lat ? outL : outC; const float* gate = gate0 + (size_t)bm * NMOD;
        const int row0 = rb + wr * 64 + fr, col0 = u.pn * 256 + wc * 32 + 4 * fq;
        f32x4 gv[2][2];
#pragma unroll
        for (int bj = 0; bj < 2; ++bj)
#pragma unroll
            for (int n = 0; n < 2; ++n) gv[bj][n] = *(const f32x4*)(gate + col0 + bj * 128 + n * 16) * s;
#pragma unroll
        for (int ai = 0; ai < 2; ++ai)
#pragma unroll
            for (int m = 0; m < 4; ++m) { const size_t off = (size_t)(row0 + ai * 128 + m * 16) * D + col0;
#pragma unroll
                for (int bj = 0; bj < 2; ++bj)
#pragma unroll
                    for (int n = 0; n < 2; ++n) { const f32x4 x = *(const f32x4*)(in + off + bj * 128 + n * 16); *(f32x4*)(out + off + bj * 128 + n * 16) = x + gv[bj][n] * acc[ai][bj][m][n]; } }
    }
};
struct EpiWin {
    static constexpr bool PERM = true, AFTER_DRAIN = false;
    bf16_t* PH; bf16_t* PQKV; bf16_t* PB; float* ABF;
    __device__ __forceinline__ void operator()(const f32x4 (&acc)[2][2][4][2], const Unit& u, int wr, int wc, int fr, int fq) const {
        const int row0 = u.pm * 256 + wr * 64 + fr, cin = wc * 32 + 8 * fq; const int pn = u.pn;
        if (pn == 28) {
            if (wc == 0) {
#pragma unroll
                for (int ai = 0; ai < 2; ++ai)
#pragma unroll
                    for (int m = 0; m < 4; ++m) { float* p = ABF + (size_t)(row0 + ai * 128 + m * 16) * 32 + 8 * fq; *(f32x4*)p = acc[ai][0][m][0]; *(f32x4*)(p + 4) = acc[ai][0][m][1]; } }
            return; }
        bf16_t* base; int ldc; bool sg = false;
        if (pn < 12) { base = PH + 256 * pn; ldc = 3072; }
        else if (pn < 24) { base = PQKV + 256 * (pn - 12); ldc = 3072; }
        else if (pn < 28) { base = PB + 256 * (pn - 24); ldc = 5120; }
        else { base = PB + 1024 + 256 * (pn - 29); ldc = 5120; sg = true; }
#pragma unroll
        for (int ai = 0; ai < 2; ++ai)
#pragma unroll
            for (int m = 0; m < 4; ++m) { bf16_t* rowp = base + (size_t)(row0 + ai * 128 + m * 16) * ldc + cin;
#pragma unroll
                for (int bj = 0; bj < 2; ++bj) { f32x4 v0 = acc[ai][bj][m][0], v1 = acc[ai][bj][m][1];
                    if (sg) {
#pragma unroll
                        for (int j = 0; j < 4; ++j) { v0[j] = sigm_f(v0[j]); v1[j] = sigm_f(v1[j]); } }
                    u32x4 w; w.x = pk2(v0[0], v0[1]); w.y = pk2(v0[2], v0[3]); w.z = pk2(v1[0], v1[1]); w.w = pk2(v1[2], v1[3]);
                    *(u32x4*)(rowp + bj * 128) = w; } }
    }
};
template <int SECOND> struct EpiMerge {
    static constexpr bool PERM = false, AFTER_DRAIN = false;
    const bf16_t* gates; float* TMP; bf16_t* OUT;
    __device__ __forceinline__ void operator()(const f32x4 (&acc)[2][2][4][2], const Unit& u, int wr, int wc, int fr, int fq) const {
        const int row0 = u.pm * 256 + wr * 64 + fr, col0 = u.pn * 256 + wc * 32 + 4 * fq;
#pragma unroll
        for (int ai = 0; ai < 2; ++ai)
#pragma unroll
            for (int m = 0; m < 4; ++m) { const size_t r = (size_t)(row0 + ai * 128 + m * 16);
#pragma unroll
                for (int bj = 0; bj < 2; ++bj)
#pragma unroll
                    for (int n = 0; n < 2; ++n) { const int c = col0 + bj * 128 + n * 16;
                        const u32x2 gw = *(const u32x2*)(gates + r * 5120 + c);
                        const f32x4 g = (f32x4){bflo(gw.x), bfhi(gw.x), bflo(gw.y), bfhi(gw.y)};
                        if (SECOND == 0) { *(f32x4*)(TMP + r * D + c) = g * acc[ai][bj][m][n]; }
                        else { const f32x4 t = *(const f32x4*)(TMP + r * D + c) + g * acc[ai][bj][m][n]; u32x2 w; w.x = pk2(t.x, t.y); w.y = pk2(t.z, t.w); *(u32x2*)(OUT + r * D + c) = w; } } }
    }
};
struct WinOrder : pg8::StaticOrder {
    __device__ bool next(int i, Unit& u) const {
        if (pg8::StaticOrder::next(i, u)) return true;
        const long L = (long)i * G + c - nwg; if (L >= 52) return false;
        const int q = (int)(L % 13); u.pm = 64 + (int)(L / 13); u.pn = q < 12 ? 12 + q : 28; return true;
    }
};

__device__ __forceinline__ void phase_mod(const float* c, const float* c_ctx, const float* w_mod, const float* b_mod, float* MOD, unsigned char* smem, int tid) {
    float* sS = (float*)smem;
    float* sR = (float*)(smem + 40960);
    const int lane = tid & 63, wv = tid >> 6;
    for (int wg = blockIdx.x; wg < 144; wg += gridDim.x) {
        const int col0 = wg * 128;
        for (int idx = tid; idx < 5 * 2048; idx += 512) { const int r = idx >> 11, k = idx & 2047; const float cv = r < 4 ? c[r * 2048 + k] : c_ctx[k]; sS[idx] = cv / (1.f + expf(-cv)); }
        __syncthreads();
        float a0[5], a1[5];
#pragma unroll
        for (int r = 0; r < 5; ++r) { a0[r] = 0.f; a1[r] = 0.f; }
        const int kb = wv * 256;
#pragma unroll 8
        for (int k = kb; k < kb + 256; ++k) {
            const f32x2 w = *(const f32x2*)(w_mod + (size_t)k * NMOD + col0 + 2 * lane);
#pragma unroll
            for (int r = 0; r < 5; ++r) { const float s = sS[r * 2048 + k]; a0[r] += s * w.x; a1[r] += s * w.y; } }
#pragma unroll
        for (int r = 0; r < 5; ++r) { sR[(wv * 5 + r) * 128 + 2 * lane] = a0[r]; sR[(wv * 5 + r) * 128 + 2 * lane + 1] = a1[r]; }
        __syncthreads();
        for (int idx = tid; idx < 5 * 128; idx += 512) { const int r = idx >> 7, cc = idx & 127; float s = 0.f;
#pragma unroll
            for (int w = 0; w < 8; ++w) s += sR[(w * 5 + r) * 128 + cc];
            MOD[(size_t)r * NMOD + col0 + cc] = s + b_mod[col0 + cc]; }
        __syncthreads();
    }
}
__device__ __forceinline__ void phase_h2(const float* w1, const float* b1, const float* w2, const float* b2, const float* freq, float* H2, int gw, int ngw, int lane) {
    for (int t = gw; t < 4096; t += ngw) {
        const float tt = (float)t * (1.f / 4096.f);
        float zf = 0.f;
        if (lane == 0) zf = tt;
        else if (lane <= 16) { const float f = 1e-4f + (float)(lane - 1) * ((15.f - 1e-4f) / 15.f); zf = cosf((6.283185307179586f * tt) * f); }
        else if (lane <= 32) { const float f = 1e-4f + (float)(lane - 17) * ((15.f - 1e-4f) / 15.f); zf = -sinf((6.283185307179586f * tt) * f); }
        float a = 0.f;
        for (int e = 0; e < 33; ++e) a += __shfl(zf, e) * w1[e * 64 + lane];
        const float fr = freq[lane];
        const float h1 = sinf(fr * (a + b1[lane]));
        float a2 = 0.f;
        for (int j = 0; j < 64; ++j) a2 += __shfl(h1, j) * w2[j * 64 + lane];
        H2[t * 64 + lane] = sinf(fr * (a2 + b2[lane]));
    }
}

__device__ __forceinline__ void phase_gdn_conv(bf16_t* PQKV, const float* conv_w, unsigned char* smem, int tid) {
    unsigned short* sRaw = (unsigned short*)smem;
    const int lane = tid & 63, wv = tid >> 6;
    for (int item = blockIdx.x; item < 6144 + 64; item += gridDim.x) {
        int r0, T, hc;
        if (item < 6144) { const int seg = item / 24; hc = item % 24; r0 = seg * 64; T = 64; }
        else { const int q = item - 6144; hc = 8 + (q & 15); r0 = ML + (q >> 4) * 256; T = 256; }
        const int col0 = hc * 128;
        for (int ch = tid; ch < T * 16; ch += 512) { const int row = ch >> 4, part = ch & 15;
            *(u32x4*)(sRaw + row * 128 + part * 8) = *(const u32x4*)(PQKV + (size_t)(r0 + row) * 3072 + col0 + part * 8); }
        const int cc = col0 + 2 * lane;
        const float w00 = conv_w[cc], w01 = conv_w[cc + 1], w10 = conv_w[3072 + cc], w11 = conv_w[3072 + cc + 1], w20 = conv_w[6144 + cc], w21 = conv_w[6144 + cc + 1];
        __syncthreads();
        for (int i = wv; i < T; i += 8) {
            const unsigned x0 = *(const unsigned*)(sRaw + i * 128 + 2 * lane);
            const unsigned xm = i > 0 ? *(const unsigned*)(sRaw + (i - 1) * 128 + 2 * lane) : 0u;
            const unsigned xp = i < T - 1 ? *(const unsigned*)(sRaw + (i + 1) * 128 + 2 * lane) : 0u;
            float y0 = w00 * bflo(xm) + w10 * bflo(x0) + w20 * bflo(xp);
            float y1 = w01 * bfhi(xm) + w11 * bfhi(x0) + w21 * bfhi(xp);
            y0 = silu_f(y0); y1 = silu_f(y1);
            if (hc < 16) { const float ss = wave_sum(y0 * y0 + y1 * y1); float sc = rsqrtf(ss + 1e-6f); if (hc < 8) sc *= 0.08838834764831845f; y0 *= sc; y1 *= sc; }
            *(unsigned*)(PQKV + (size_t)(r0 + i) * 3072 + cc) = pk2(y0, y1);
        }
        __syncthreads();
    }
}
__device__ __forceinline__ void phase_gbeta(const float* ABF, const float* a_log, const float* dt_bias, float* G, float* BETA, int gtid, int ngt) {
    for (int idx = gtid; idx < MT * 16; idx += ngt) { const int r = idx >> 4, e = idx & 15;
        const float a = ABF[(size_t)r * 32 + e] + dt_bias[e], bb = ABF[(size_t)r * 32 + 16 + e];
        const float sp = a > 20.f ? a : log1pf(expf(a));
        G[idx] = -expf(a_log[e]) * sp; BETA[idx] = 1.f / (1.f + expf(-bb)); }
}

__device__ __forceinline__ int chunk_row(int item, int i, int& h, int& dir) {
    int n, b, Ls, rb;
    if (item < 4096) { n = item & 63; h = (item >> 6) & 7; b = (item >> 9) & 3; dir = item >> 11; Ls = SEQ; rb = b * SEQ; }
    else { const int q = item - 4096; n = q & 3; h = (q >> 2) & 7; b = (q >> 5) & 3; dir = q >> 7; Ls = CTXL; rb = ML + b * CTXL; }
    const int p = n * 64 + i;
    return rb + (dir ? Ls - 1 - p : p);
}
__device__ __forceinline__ void phase_gdn_prep(const bf16_t* PQKV, const float* G, const float* BETA, bf16_t* U, bf16_t* W, bf16_t* QK, float* GC, unsigned char* smem, int tid) {
    float* sK = (float*)smem;
    float* sQ = sK + 64 * 132;
    float* sV = sQ + 64 * 132;
    float* sT = sV + 64 * 128;
    float* sGc = sT + 64 * 68;
    float* sBe = sGc + 64;
    float* sBg = sBe + 64;
    const int lane = tid & 63, wv = tid >> 6;
    for (int item = blockIdx.x; item < NITEM; item += gridDim.x) {
        int h, dir;
        {
            const int i = tid >> 3, part = tid & 7; const int row = chunk_row(item, i, h, dir);
            const bf16_t* src = PQKV + (size_t)row * 3072 + h * 128 + part * 16;
            const float be = BETA[(size_t)row * 16 + dir * 8 + h];
#pragma unroll
            for (int hh = 0; hh < 2; ++hh) {
                const u32x4 q = *(const u32x4*)(src + hh * 8), k = *(const u32x4*)(src + 1024 + hh * 8), v = *(const u32x4*)(src + 2048 + hh * 8);
                float* dq = sQ + i * 132 + part * 16 + hh * 8; float* dk = sK + i * 132 + part * 16 + hh * 8; float* dv = sV + i * 128 + part * 16 + hh * 8;
                *(f32x4*)dq = (f32x4){bflo(q.x), bfhi(q.x), bflo(q.y), bfhi(q.y)}; *(f32x4*)(dq + 4) = (f32x4){bflo(q.z), bfhi(q.z), bflo(q.w), bfhi(q.w)};
                *(f32x4*)dk = (f32x4){bflo(k.x), bfhi(k.x), bflo(k.y), bfhi(k.y)}; *(f32x4*)(dk + 4) = (f32x4){bflo(k.z), bfhi(k.z), bflo(k.w), bfhi(k.w)};
                *(f32x4*)dv = (f32x4){bflo(v.x), bfhi(v.x), bflo(v.y), bfhi(v.y)} * be; *(f32x4*)(dv + 4) = (f32x4){bflo(v.z), bfhi(v.z), bflo(v.w), bfhi(v.w)} * be;
            }
        }
        if (wv == 0) {
            int hh, dd; const int row = chunk_row(item, lane, hh, dd);
            float g = G[(size_t)row * 16 + dd * 8 + hh]; const float be = BETA[(size_t)row * 16 + dd * 8 + hh];
#pragma unroll
            for (int o = 1; o < 64; o <<= 1) { const float t = __shfl_up(g, o); if (lane >= o) g += t; }
            sGc[lane] = g; sBe[lane] = be; sBg[lane] = be * expf(g);
            GC[(size_t)item * 64 + lane] = g;
        }
        __syncthreads();
        {
            const int j = lane; const float gj = sGc[j];
            float ak[8], aq[8];
#pragma unroll
            for (int ii = 0; ii < 8; ++ii) { ak[ii] = 0.f; aq[ii] = 0.f; }
            for (int d = 0; d < 128; d += 4) {
                const f32x4 kj = *(const f32x4*)(sK + j * 132 + d);
#pragma unroll
                for (int ii = 0; ii < 8; ++ii) { const int i = wv * 8 + ii;
                    const f32x4 ki = *(const f32x4*)(sK + i * 132 + d), qi = *(const f32x4*)(sQ + i * 132 + d);
                    ak[ii] += (ki.x * kj.x + ki.y * kj.y) + (ki.z * kj.z + ki.w * kj.w);
                    aq[ii] += (qi.x * kj.x + qi.y * kj.y) + (qi.z * kj.z + qi.w * kj.w); } }
#pragma unroll
            for (int ii = 0; ii < 8; ++ii) { const int i = wv * 8 + ii; const float dec = i >= j ? expf(sGc[i] - gj) : 0.f;
                sT[i * 68 + j] = i > j ? sBe[i] * ak[ii] * dec : 0.f;
                QK[((size_t)item * 64 + i) * 64 + j] = pg8::cvt_pk_bf16(aq[ii] * dec, 0.f) & 0xffffu; }
        }
        __syncthreads();
        if (wv == 0) {
            for (int i = 0; i < 64; ++i) {
                float a = (i == lane) ? 1.f : 0.f;
                for (int j = 0; j < i; ++j) a -= sT[i * 68 + j] * sT[j * 68 + lane];
                LDS_WAIT();
                sT[i * 68 + lane] = a;
                LDS_WAIT();
            }
        }
        __syncthreads();
        {
            const int d = tid & 127, ig = tid >> 7;
            float au[16], aw[16];
#pragma unroll
            for (int ii = 0; ii < 16; ++ii) { au[ii] = 0.f; aw[ii] = 0.f; }
            for (int j0 = 0; j0 < 16 * (ig + 1); j0 += 4) {
                float vb[4], kb[4];
#pragma unroll
                for (int jj = 0; jj < 4; ++jj) { vb[jj] = sV[(j0 + jj) * 128 + d]; kb[jj] = sK[(j0 + jj) * 132 + d] * sBg[j0 + jj]; }
#pragma unroll
                for (int ii = 0; ii < 16; ++ii) { const f32x4 t = *(const f32x4*)(sT + (ig * 16 + ii) * 68 + j0);
                    au[ii] += (t.x * vb[0] + t.y * vb[1]) + (t.z * vb[2] + t.w * vb[3]);
                    aw[ii] += (t.x * kb[0] + t.y * kb[1]) + (t.z * kb[2] + t.w * kb[3]); } }
#pragma unroll
            for (int ii = 0; ii < 16; ++ii) { const size_t o = ((size_t)item * 64 + ig * 16 + ii) * 128 + d;
                U[o] = (bf16_t)(pg8::cvt_pk_bf16(au[ii], 0.f) & 0xffffu); W[o] = (bf16_t)(pg8::cvt_pk_bf16(aw[ii], 0.f) & 0xffffu); }
        }
        __syncthreads();
    }
}

__device__ __forceinline__ void phase_scan(const bf16_t* PQKV, const bf16_t* U, const bf16_t* W, const bf16_t* QK, const float* GC, bf16_t* O, unsigned char* smem, int tid) {
    float* sW = (float*)smem;
    float* sQ = sW + 64 * 132;
    float* sK = sQ + 64 * 132;
    float* sQK = sK + 64 * 132;
    float* sS = sQK + 64 * 68;
    float* sVn = sS + 128 * 32;
    float* sGc = sVn + 64 * 32;
    float* sEg = sGc + 64;
    float* sEd = sEg + 64;
    const int e = tid & 31, ig = tid >> 5;
    for (int wg = blockIdx.x; wg < 256; wg += gridDim.x) {
        const int dir = wg >> 7, b = (wg >> 5) & 3, h = (wg >> 2) & 7, sl = wg & 3;
        const int dbh = (dir * 4 + b) * 8 + h;
        __syncthreads();
        for (int idx = tid; idx < 4096; idx += 512) sS[idx] = 0.f;
        u32x4 wreg[2], kreg[2], qreg[2], qkreg; unsigned short ureg[4]; float gcreg = 0.f;
        qreg[0] = qreg[1] = qkreg = (u32x4){0u, 0u, 0u, 0u};
#define SCAN_LOAD(step_) do { const int st_ = (step_); const bool lat_ = st_ >= 4; const int item_ = lat_ ? dbh * 64 + (st_ - 4) : 4096 + dbh * 4 + st_; \
            const int n_ = lat_ ? st_ - 4 : st_; const int Ls_ = lat_ ? SEQ : CTXL; const int rb_ = lat_ ? b * SEQ : ML + b * CTXL; \
            const bf16_t* wp_ = W + (size_t)item_ * 8192 + tid * 8; wreg[0] = *(const u32x4*)wp_; wreg[1] = *(const u32x4*)(wp_ + 4096); \
            { const int i_ = tid >> 3, part_ = tid & 7; const int p_ = n_ * 64 + i_; const int row_ = rb_ + (dir ? Ls_ - 1 - p_ : p_); \
              const bf16_t* kp_ = PQKV + (size_t)row_ * 3072 + 1024 + h * 128 + part_ * 16; kreg[0] = *(const u32x4*)kp_; kreg[1] = *(const u32x4*)(kp_ + 8); \
              if (lat_) { qreg[0] = *(const u32x4*)(kp_ - 1024); qreg[1] = *(const u32x4*)(kp_ - 1024 + 8); } } \
            if (lat_) qkreg = *(const u32x4*)(QK + (size_t)item_ * 4096 + tid * 8); \
            _Pragma("unroll") for (int ii_ = 0; ii_ < 4; ++ii_) ureg[ii_] = U[((size_t)item_ * 64 + ig * 4 + ii_) * 128 + sl * 32 + e]; \
            if (tid < 64) gcreg = GC[(size_t)item_ * 64 + tid]; } while (0)
        SCAN_LOAD(0);
        for (int step = 0; step < 68; ++step) {
            const bool lat = step >= 4;
            __syncthreads();
            {
                { const int r = tid >> 4, cc = (tid & 15) * 8;
#pragma unroll
                  for (int hh = 0; hh < 2; ++hh) { float* d = sW + (r + 32 * hh) * 132 + cc; const u32x4 w = wreg[hh];
                      *(f32x4*)d = (f32x4){bflo(w.x), bfhi(w.x), bflo(w.y), bfhi(w.y)}; *(f32x4*)(d + 4) = (f32x4){bflo(w.z), bfhi(w.z), bflo(w.w), bfhi(w.w)}; } }
                { const int i = tid >> 3, part = tid & 7;
#pragma unroll
                  for (int hh = 0; hh < 2; ++hh) { float* dk = sK + i * 132 + part * 16 + hh * 8; const u32x4 k = kreg[hh];
                      *(f32x4*)dk = (f32x4){bflo(k.x), bfhi(k.x), bflo(k.y), bfhi(k.y)}; *(f32x4*)(dk + 4) = (f32x4){bflo(k.z), bfhi(k.z), bflo(k.w), bfhi(k.w)};
                      if (lat) { float* dq = sQ + i * 132 + part * 16 + hh * 8; const u32x4 q = qreg[hh];
                          *(f32x4*)dq = (f32x4){bflo(q.x), bfhi(q.x), bflo(q.y), bfhi(q.y)}; *(f32x4*)(dq + 4) = (f32x4){bflo(q.z), bfhi(q.z), bflo(q.w), bfhi(q.w)}; } } }
                if (lat) { const int r = tid >> 3, cc = (tid & 7) * 8; float* d = sQK + r * 68 + cc; const u32x4 w = qkreg;
                    *(f32x4*)d = (f32x4){bflo(w.x), bfhi(w.x), bflo(w.y), bfhi(w.y)}; *(f32x4*)(d + 4) = (f32x4){bflo(w.z), bfhi(w.z), bflo(w.w), bfhi(w.w)}; }
                if (tid < 64) { const float gl = __shfl(gcreg, 63); sGc[tid] = gcreg; sEg[tid] = expf(gcreg); sEd[tid] = expf(gl - gcreg); }
            }
            float av[4], ao[4];
#pragma unroll
            for (int ii = 0; ii < 4; ++ii) { av[ii] = bf2f(ureg[ii]); ao[ii] = 0.f; }
            if (step + 1 < 68) SCAN_LOAD(step + 1);
            __syncthreads();
            for (int dk0 = 0; dk0 < 128; dk0 += 4) {
                const float s0 = sS[(dk0 + 0) * 32 + e], s1 = sS[(dk0 + 1) * 32 + e], s2 = sS[(dk0 + 2) * 32 + e], s3 = sS[(dk0 + 3) * 32 + e];
#pragma unroll
                for (int ii = 0; ii < 4; ++ii) { const int i = ig * 4 + ii;
                    const f32x4 w = *(const f32x4*)(sW + i * 132 + dk0);
                    av[ii] -= (w.x * s0 + w.y * s1) + (w.z * s2 + w.w * s3);
                    if (lat) { const f32x4 q = *(const f32x4*)(sQ + i * 132 + dk0); ao[ii] += (q.x * s0 + q.y * s1) + (q.z * s2 + q.w * s3); } } }
#pragma unroll
            for (int ii = 0; ii < 4; ++ii) sVn[(ig * 4 + ii) * 32 + e] = av[ii];
            __syncthreads();
            if (lat) {
#pragma unroll
                for (int ii = 0; ii < 4; ++ii) ao[ii] *= sEg[ig * 4 + ii];
                for (int j0 = 0; j0 < ig * 4 + 4; j0 += 4) {
                    const float v0 = sVn[(j0 + 0) * 32 + e], v1 = sVn[(j0 + 1) * 32 + e], v2 = sVn[(j0 + 2) * 32 + e], v3 = sVn[(j0 + 3) * 32 + e];
#pragma unroll
                    for (int ii = 0; ii < 4; ++ii) { const f32x4 q = *(const f32x4*)(sQK + (ig * 4 + ii) * 68 + j0); ao[ii] += (q.x * v0 + q.y * v1) + (q.z * v2 + q.w * v3); } }
                const int n = step - 4;
#pragma unroll
                for (int ii = 0; ii < 4; ++ii) { const int p = n * 64 + ig * 4 + ii; const int pos = dir ? SEQ - 1 - p : p;
                    O[((size_t)dir * ML + (size_t)b * SEQ + pos) * 1024 + h * 128 + sl * 32 + e] = (bf16_t)(pg8::cvt_pk_bf16(ao[ii], 0.f) & 0xffffu); }
            }
            {
                const int kg = ig; const float egl = sEg[63];
                float as[8];
#pragma unroll
                for (int kk = 0; kk < 8; ++kk) as[kk] = sS[(kg * 8 + kk) * 32 + e] * egl;
                for (int i = 0; i < 64; ++i) { const float vn = sVn[i * 32 + e] * sEd[i];
                    const f32x4 k0 = *(const f32x4*)(sK + i * 132 + kg * 8), k1 = *(const f32x4*)(sK + i * 132 + kg * 8 + 4);
                    as[0] += k0.x * vn; as[1] += k0.y * vn; as[2] += k0.z * vn; as[3] += k0.w * vn;
                    as[4] += k1.x * vn; as[5] += k1.y * vn; as[6] += k1.z * vn; as[7] += k1.w * vn; }
#pragma unroll
                for (int kk = 0; kk < 8; ++kk) sS[(kg * 8 + kk) * 32 + e] = as[kk];
            }
        }
#undef SCAN_LOAD
    }
}

__device__ __forceinline__ void phase_ogate(bf16_t* O, const bf16_t* PB, const float* gn, int gw, int ngw, int lane) {
    for (int r = gw; r < ML; r += ngw) {
        bf16_t* of = O + (size_t)r * 1024 + lane * 16; const bf16_t* ob = of + (size_t)ML * 1024; const bf16_t* zp = PB + (size_t)r * 5120 + lane * 16;
        float o[16], z[16];
#pragma unroll
        for (int hh = 0; hh < 2; ++hh) { const u32x4 a = *(const u32x4*)(of + hh * 8), bq = *(const u32x4*)(ob + hh * 8), zz = *(const u32x4*)(zp + hh * 8);
            o[hh * 8 + 0] = bflo(a.x) + bflo(bq.x); o[hh * 8 + 1] = bfhi(a.x) + bfhi(bq.x); o[hh * 8 + 2] = bflo(a.y) + bflo(bq.y); o[hh * 8 + 3] = bfhi(a.y) + bfhi(bq.y);
            o[hh * 8 + 4] = bflo(a.z) + bflo(bq.z); o[hh * 8 + 5] = bfhi(a.z) + bfhi(bq.z); o[hh * 8 + 6] = bflo(a.w) + bflo(bq.w); o[hh * 8 + 7] = bfhi(a.w) + bfhi(bq.w);
            z[hh * 8 + 0] = bflo(zz.x); z[hh * 8 + 1] = bfhi(zz.x); z[hh * 8 + 2] = bflo(zz.y); z[hh * 8 + 3] = bfhi(zz.y);
            z[hh * 8 + 4] = bflo(zz.z); z[hh * 8 + 5] = bfhi(zz.z); z[hh * 8 + 6] = bflo(zz.w); z[hh * 8 + 7] = bfhi(zz.w); }
        float ss = 0.f;
#pragma unroll
        for (int j = 0; j < 16; ++j) ss += o[j] * o[j];
        ss += __shfl_xor(ss, 1); ss += __shfl_xor(ss, 2); ss += __shfl_xor(ss, 4);
        const float rstd = rsqrtf(ss * (1.f / 128.f) + 1e-6f);
        const float* g = gn + (lane & 7) * 16;
        u32x4 w[2];
#pragma unroll
        for (int hh = 0; hh < 2; ++hh) {
            float r8[8];
#pragma unroll
            for (int j = 0; j < 8; ++j) r8[j] = o[hh * 8 + j] * rstd * g[hh * 8 + j] * silu_f(z[hh * 8 + j]);
            w[hh].x = pk2(r8[0], r8[1]); w[hh].y = pk2(r8[2], r8[3]); w[hh].z = pk2(r8[4], r8[5]); w[hh].w = pk2(r8[6], r8[7]); }
        *(u32x4*)of = w[0]; *(u32x4*)(of + 8) = w[1];
    }
}
__device__ __forceinline__ void phase_hy_tin(const bf16_t* PH, const float* cw, const float* cb, bf16_t* HYT, unsigned char* smem, int tid) {
    float* sT = (float*)smem;
    for (int item = blockIdx.x; item < 4 * 64 * 48; item += gridDim.x) {
        const int cbk = item % 48, seg = (item / 48) & 63, b = item / (48 * 64);
        const int r0 = b * SEQ + seg * 64;
        { const int row = tid >> 3, part = tid & 7; const u32x4 x = *(const u32x4*)(PH + (size_t)(r0 + row) * 3072 + cbk * 64 + part * 8); float* d = sT + row * 65 + part * 8;
          d[0] = bflo(x.x); d[1] = bfhi(x.x); d[2] = bflo(x.y); d[3] = bfhi(x.y); d[4] = bflo(x.z); d[5] = bfhi(x.z); d[6] = bflo(x.w); d[7] = bfhi(x.w); }
        __syncthreads();
        { const int j = tid >> 3, i8 = tid & 7; const int col = cbk * 64 + j;
          const float w0 = cw[col], w1 = cw[3072 + col], w2 = cw[6144 + col], bi = cb[col];
          float y[8];
#pragma unroll
          for (int ii = 0; ii < 8; ++ii) { const int i = i8 * 8 + ii; const float xm = i > 0 ? sT[(i - 1) * 65 + j] : 0.f, x0 = sT[i * 65 + j], xp = i < 63 ? sT[(i + 1) * 65 + j] : 0.f;
              y[ii] = w0 * xm + w1 * x0 + w2 * xp + bi; }
          u32x4 w; w.x = pk2(y[0], y[1]); w.y = pk2(y[2], y[3]); w.z = pk2(y[4], y[5]); w.w = pk2(y[6], y[7]);
          *(u32x4*)(HYT + ((size_t)col * 4 + b) * 4096 + seg * 64 + i8 * 8) = w; }
        __syncthreads();
    }
}
__device__ __forceinline__ f32x2 cmul(f32x2 a, f32x2 b) { return (f32x2){a.x * b.x - a.y * b.y, a.x * b.y + a.y * b.x}; }
__device__ __forceinline__ f32x2 twid(const f32x2* TW, int k) { f32x2 w = TW[k & 2047]; if (k & 2048) w = (f32x2){w.y, -w.x}; return w; }
__device__ __forceinline__ void tw_init(f32x2* TW, int tid) {
    for (int k = tid; k < 2048; k += 512) { float s, c; sincospif((float)k * (1.f / 4096.f), &s, &c); TW[k] = (f32x2){c, -s}; }
}
__device__ __forceinline__ void fft_fwd(f32x2* X, const f32x2* TW, int tid) {
    for (int s = 0; s < 13; ++s) { const int lh = 12 - s, h = 1 << lh;
#pragma unroll
        for (int u = 0; u < 8; ++u) { const int q = tid + 512 * u, j = q & (h - 1), i0 = ((q >> lh) << (lh + 1)) | j, i1 = i0 + h;
            const f32x2 a = X[i0], b = X[i1], w = twid(TW, j << s); X[i0] = a + b; X[i1] = cmul(a - b, w); }
        __syncthreads(); }
}
__device__ __forceinline__ void fft_inv(f32x2* X, const f32x2* TW, int tid) {
    for (int s = 12; s >= 0; --s) { const int lh = 12 - s, h = 1 << lh;
#pragma unroll
        for (int u = 0; u < 8; ++u) { const int q = tid + 512 * u, j = q & (h - 1), i0 = ((q >> lh) << (lh + 1)) | j, i1 = i0 + h;
            f32x2 w = twid(TW, j << s); w.y = -w.y; const f32x2 a = X[i0], b = cmul(X[i1], w); X[i0] = a + b; X[i1] = a - b; }
        __syncthreads(); }
}
__device__ __forceinline__ void phase_hy_filt(const float* H2, const float* w3, f32x2* KFS, unsigned char* smem, int tid) {
    f32x2* X = (f32x2*)smem; f32x2* TW = (f32x2*)(smem + 65536); float* sW3 = (float*)(smem + 65536 + 16384); float* sRed = sW3 + 128;
    const int lane = tid & 63, wv = tid >> 6;
    tw_init(TW, tid);
    for (int item = blockIdx.x; item < 2048; item += gridDim.x) {
        const int o = item >> 10, c = item & 1023; const int colf = o * 2048 + c;
        __syncthreads();
        if (tid < 128) sW3[tid] = w3[(size_t)(tid & 63) * 4096 + colf + (tid >> 6) * 1024];
        const float a0 = -3.0701134573253945f, a1 = -15.350567286626973f;
        const float delta = fabsf(a0 + (float)c * ((a1 - a0) / 1023.f));
        __syncthreads();
        float sabs = 0.f;
#pragma unroll 1
        for (int u = 0; u < 8; ++u) { const int t = tid + 512 * u; float hf = 0.f, hb = 0.f;
#pragma unroll
            for (int j4 = 0; j4 < 16; ++j4) { const f32x4 hv = *(const f32x4*)(H2 + (size_t)t * 64 + j4 * 4);
                hf += (hv.x * sW3[j4 * 4] + hv.y * sW3[j4 * 4 + 1]) + (hv.z * sW3[j4 * 4 + 2] + hv.w * sW3[j4 * 4 + 3]);
                hb += (hv.x * sW3[64 + j4 * 4] + hv.y * sW3[64 + j4 * 4 + 1]) + (hv.z * sW3[64 + j4 * 4 + 2] + hv.w * sW3[64 + j4 * 4 + 3]); }
            const float dec = expf(-((float)t * (1.f / 4096.f)) * delta); hf *= dec; hb *= dec; sabs += fabsf(hf) + fabsf(hb);
            X[t] = (f32x2){hf, 0.f};
            if (t > 0) X[8192 - t] = (f32x2){hb, 0.f}; else X[4096] = (f32x2){0.f, 0.f}; }
        sabs = wave_sum(sabs);
        if (lane == 0) sRed[wv] = sabs;
        __syncthreads();
        float nrm = 0.f;
#pragma unroll
        for (int w = 0; w < 8; ++w) nrm += sRed[w];
        fft_fwd(X, TW, tid);
        const float sc = 1.f / (nrm * 8192.f);
        f32x2* dst = KFS + (size_t)item * 8192;
        for (int p = tid; p < 8192; p += 512) dst[p] = X[p] * sc;
    }
}
__device__ __forceinline__ void unpack8(const u32x4 x, float* d) { d[0] = bflo(x.x); d[1] = bfhi(x.x); d[2] = bflo(x.y); d[3] = bfhi(x.y); d[4] = bflo(x.z); d[5] = bfhi(x.z); d[6] = bflo(x.w); d[7] = bfhi(x.w); }
__device__ __forceinline__ void phase_hy_main(bf16_t* HYT, const f32x2* KFS, const float* hy_bias, unsigned char* smem, int tid) {
    f32x2* X = (f32x2*)smem; f32x2* TW = (f32x2*)(smem + 65536); f32x2* Z1 = (f32x2*)(smem + 65536 + 16384);
    tw_init(TW, tid);
    for (int item = blockIdx.x; item < 2048; item += gridDim.x) {
        const int c = item >> 1, b0 = (item & 1) * 2; const int t0 = tid * 8;
        bf16_t* v0 = HYT + ((size_t)c * 4 + b0) * 4096 + t0; bf16_t* v1 = v0 + 4096;
        const bf16_t* x10 = HYT + ((size_t)(1024 + c) * 4 + b0) * 4096 + t0; const bf16_t* x20 = HYT + ((size_t)(2048 + c) * 4 + b0) * 4096 + t0;
        const float bias1 = hy_bias[c], bias2 = hy_bias[1024 + c];
        float va[8], vb[8];
        unpack8(*(const u32x4*)v0, va); unpack8(*(const u32x4*)v1, vb);
        __syncthreads();
#pragma unroll
        for (int e = 0; e < 8; ++e) { X[t0 + e] = (f32x2){va[e], vb[e]}; X[4096 + t0 + e] = (f32x2){0.f, 0.f}; }
        __syncthreads();
        fft_fwd(X, TW, tid);
        { const f32x2* kf = KFS + (size_t)c * 8192; for (int p = tid; p < 8192; p += 512) X[p] = cmul(X[p], kf[p]); }
        __syncthreads();
        fft_inv(X, TW, tid);
        { float xa[8], xb[8]; unpack8(*(const u32x4*)x10, xa); unpack8(*(const u32x4*)(x10 + 4096), xb);
#pragma unroll
          for (int e = 0; e < 8; ++e) { const f32x2 y = X[t0 + e]; const f32x2 z = (f32x2){xa[e] * (y.x + va[e] * bias1), xb[e] * (y.y + vb[e] * bias1)};
              Z1[t0 + e] = z; X[t0 + e] = z; X[4096 + t0 + e] = (f32x2){0.f, 0.f}; } }
        __syncthreads();
        fft_fwd(X, TW, tid);
        { const f32x2* kf = KFS + (size_t)(1024 + c) * 8192; for (int p = tid; p < 8192; p += 512) X[p] = cmul(X[p], kf[p]); }
        __syncthreads();
        fft_inv(X, TW, tid);
        { float xa[8], xb[8], ra[8], rb[8]; unpack8(*(const u32x4*)x20, xa); unpack8(*(const u32x4*)(x20 + 4096), xb);
#pragma unroll
          for (int e = 0; e < 8; ++e) { const f32x2 y = X[t0 + e], z = Z1[t0 + e]; ra[e] = xa[e] * (y.x + z.x * bias2); rb[e] = xb[e] * (y.y + z.y * bias2); }
          u32x4 w; w.x = pk2(ra[0], ra[1]); w.y = pk2(ra[2], ra[3]); w.z = pk2(ra[4], ra[5]); w.w = pk2(ra[6], ra[7]); *(u32x4*)v0 = w;
          w.x = pk2(rb[0], rb[1]); w.y = pk2(rb[2], rb[3]); w.z = pk2(rb[4], rb[5]); w.w = pk2(rb[6], rb[7]); *(u32x4*)v1 = w; }
    }
}
__device__ __forceinline__ void phase_hy_tout(const bf16_t* HYT, bf16_t* Z2, unsigned char* smem, int tid) {
    unsigned short* sT = (unsigned short*)smem;
    for (int item = blockIdx.x; item < 4 * 64 * 16; item += gridDim.x) {
        const int cbk = item & 15, tb = (item >> 4) & 63, b = item >> 10;
        { const int j = tid >> 3, part = tid & 7; *(u32x4*)(sT + j * 72 + part * 8) = *(const u32x4*)(HYT + ((size_t)(cbk * 64 + j) * 4 + b) * 4096 + tb * 64 + part * 8); }
        __syncthreads();
        { const int i = tid >> 3, part = tid & 7; unsigned short r[8];
#pragma unroll
          for (int jj = 0; jj < 8; ++jj) r[jj] = sT[(part * 8 + jj) * 72 + i];
          u32x4 w; w.x = r[0] | ((unsigned)r[1] << 16); w.y = r[2] | ((unsigned)r[3] << 16); w.z = r[4] | ((unsigned)r[5] << 16); w.w = r[6] | ((unsigned)r[7] << 16);
          *(u32x4*)(Z2 + (size_t)(b * SEQ + tb * 64 + i) * 1024 + cbk * 64 + part * 8) = w; }
        __syncthreads();
    }
}

constexpr int N_PHASES = 18;
__global__ void __launch_bounds__(512, 2) mk_fwd(Args a) {
    extern __shared__ __attribute__((aligned(16))) unsigned char smem[];
    const int tid = threadIdx.x, lane = tid & 63, wv = tid >> 6;
    const int G = gridDim.x, bid = blockIdx.x;
    const int gw = bid * 8 + wv, ngw = G * 8, gtid = bid * 512 + tid, ngt = G * 512;
    unsigned char* ws = a.ws;
    const float* x = a.in[0]; const float* ctx = a.in[2]; const float* norm_g = a.in[6];
    float* out = a.out;
    float* MOD = (float*)(ws + OFF_MOD); float* H2 = (float*)(ws + OFF_H2); float* HC = (float*)(ws + OFF_HC); float* ABF = (float*)(ws + OFF_ABF);
    float* Gd = (float*)(ws + OFF_G); float* BETA = (float*)(ws + OFF_BETA);
    bf16_t* XN = (bf16_t*)(ws + OFF_XN); bf16_t* WA = (bf16_t*)(ws + OFF_WA); bf16_t* WAD = (bf16_t*)(ws + OFF_WA_D); bf16_t* WB = (bf16_t*)(ws + OFF_WB);
    bf16_t* ACT = (bf16_t*)(ws + OFF_ACT); bf16_t* PH = (bf16_t*)(ws + OFF_PH); bf16_t* PQKV = (bf16_t*)(ws + OFF_PQKV); bf16_t* PB = (bf16_t*)(ws + OFF_PB);
    bf16_t* Ob = (bf16_t*)(ws + OFF_O);
    bf16_t* Ub = (bf16_t*)(ws + OFF_U); bf16_t* Wb = (bf16_t*)(ws + OFF_W); bf16_t* QKb = (bf16_t*)(ws + OFF_QK); float* GC = (float*)(ws + OFF_GC);
    f32x2* KFS = (f32x2*)(ws + OFF_KFS); bf16_t* HYT = (bf16_t*)(ws + OFF_HYT); bf16_t* Z2 = (bf16_t*)(ws + OFF_Z2); float* TMP = (float*)(ws + OFF_TMP);
    bf16_t* WHY = (bf16_t*)(ws + OFF_WHY); bf16_t* WGD = (bf16_t*)(ws + OFF_WGD); bf16_t* WO = (bf16_t*)(ws + OFF_WO);
    PG8_LAS unsigned char* lds = (PG8_LAS unsigned char*)smem;
    const int lo = a.ph_lo, hi = a.ph_hi;
#ifndef PH_MASK
#define PH_MASK 0x3ffff
#endif
#define IN(k) (((PH_MASK >> (k)) & 1) && lo <= (k) && (k) < hi)
#define SEAM(k) do { if ((k) + 1 < hi) cg::this_grid().sync(); } while (0)

    if (IN(0)) {
        phase_mod(a.in[1], a.in[3], a.in[4], a.in[5], MOD, smem, tid);
        phase_h2(a.in[14], a.in[15], a.in[16], a.in[17], a.in[19], H2, gw, ngw, lane);
        __syncthreads();
        float* scr = (float*)(smem + wv * 8448);
        constexpr int I1 = 32 * 352, I2 = 88 * 64, I3 = 32 * 360;
        for (int it = gw; it < I1 + I2 + I3; it += ngw) {
            if (it < I1) conv_matrix(a.in[7], D, 2 * FF, WA, 2 * FF, 1, it, scr, lane);
            else if (it < I1 + I2) conv_matrix(a.in[8], FF, D, WAD, D, 0, it - I1, scr, lane);
            else conv_matrix(a.in[11], D, 11296, WB, NIN, 2, it - I1 - I2, scr, lane);
        }
        SEAM(0);
    }
    if (IN(1)) {
        for (int r = gw; r < MT; r += ngw) { const bool lat = r < ML; const int bm = lat ? (r >> 12) : 4;
            const float* src = lat ? x + (size_t)r * D : ctx + (size_t)(r - ML) * D; const float* m = MOD + (size_t)bm * NMOD;
            norm_ada_row(src, norm_g, m, m + D, XN + (size_t)r * D, lane); }
        SEAM(1);
    }
    if (IN(2)) {
        pg8::Gemm g{XN, WA, MT, 2 * FF, D}; pg8::StaticOrder S; S.init(MT, 2 * FF, G, bid);
        EpiSwiglu E{ACT, FF};
        pg8::gemm_phase<EpiSwiglu, pg8::StaticOrder>(lds, g, S, E, nullptr);
        SEAM(2);
    }
    if (IN(3)) {
        pg8::Gemm g{ACT, WAD, MT, D, FF}; pg8::StaticOrder S; S.init(MT, D, G, bid);
        EpiResid E{x, ctx, out, HC, MOD + 2 * D, 0.5f};
        pg8::gemm_phase<EpiResid, pg8::StaticOrder>(lds, g, S, E, nullptr);
        SEAM(3);
    }
    if (IN(4)) {
        for (int r = gw; r < MT; r += ngw) { const bool lat = r < ML; const int bm = lat ? (r >> 12) : 4;
            const float* src = lat ? out + (size_t)r * D : HC + (size_t)(r - ML) * D; const float* m = MOD + (size_t)bm * NMOD;
            norm_ada_row(src, norm_g + D, m + 3 * D, m + 4 * D, XN + (size_t)r * D, lane); }
        SEAM(4);
    }
    if (IN(5)) {
        pg8::Gemm g{XN, WB, MT, NIN, D}; WinOrder S; S.init(ML, NIN, G, bid);
        EpiWin E{PH, PQKV, PB, ABF};
        pg8::gemm_phase<EpiWin, WinOrder>(lds, g, S, E, nullptr);
        SEAM(5);
    }
    if (IN(6)) {
        phase_gbeta(ABF, a.in[23], a.in[24], Gd, BETA, gtid, ngt);
        phase_gdn_conv(PQKV, a.in[22], smem, tid);
        SEAM(6);
    }
    if (IN(7)) {
        phase_gdn_prep(PQKV, Gd, BETA, Ub, Wb, QKb, GC, smem, tid);
        SEAM(7);
    }
    if (IN(8)) {
        phase_scan(PQKV, Ub, Wb, QKb, GC, Ob, smem, tid);
        SEAM(8);
    }
    if (IN(9)) {
        phase_ogate(Ob, PB, a.in[25], gw, ngw, lane);
        phase_hy_tin(PH, a.in[12], a.in[13], HYT, smem, tid);
        __syncthreads();
        phase_hy_filt(H2, a.in[18], KFS, smem, tid);
        __syncthreads();
        float* scr = (float*)(smem + wv * 8448);
        constexpr int I1 = 16 * 64, I2 = 16 * 64, I3 = 32 * 64;
        for (int it = gw; it < I1 + I2 + I3; it += ngw) {
            if (it < I1) conv_matrix(a.in[21], 1024, D, WHY, D, 0, it, scr, lane);
            else if (it < I1 + I2) conv_matrix(a.in[26], 1024, D, WGD, D, 0, it - I1, scr, lane);
            else conv_matrix(a.in[27], D, D, WO, D, 0, it - I1 - I2, scr, lane);
        }
        SEAM(9);
    }
    if (IN(10)) {
        phase_hy_main(HYT, KFS, a.in[20], smem, tid);
        SEAM(10);
    }
    if (IN(11)) {
        phase_hy_tout(HYT, Z2, smem, tid);
        __syncthreads();
        float* scr = (float*)(smem + wv * 8448);
        constexpr int I1 = 32 * 352, I2 = 88 * 64;
        for (int it = gw; it < I1 + I2; it += ngw) {
            if (it < I1) conv_matrix(a.in[9], D, 2 * FF, WA, 2 * FF, 1, it, scr, lane);
            else conv_matrix(a.in[10], FF, D, WAD, D, 0, it - I1, scr, lane);
        }
        SEAM(11);
    }
    if (IN(12)) {
        { pg8::Gemm g{Z2, WHY, ML, D, 1024}; pg8::StaticOrder S; S.init(ML, D, G, bid);
          EpiMerge<0> E{PB + 1024, TMP, nullptr};
          pg8::gemm_phase<EpiMerge<0>, pg8::StaticOrder>(lds, g, S, E, nullptr); }
        { pg8::Gemm g{Ob, WGD, ML, D, 1024}; pg8::StaticOrder S; S.init(ML, D, G, bid);
          EpiMerge<1> E{PB + 1024 + 2048, TMP, XN};
          pg8::gemm_phase<EpiMerge<1>, pg8::StaticOrder>(lds, g, S, E, nullptr); }
        SEAM(12);
    }
    if (IN(13)) {
        pg8::Gemm g{XN, WO, ML, D, D}; pg8::StaticOrder S; S.init(ML, D, G, bid);
        EpiResid E{out, out, out, out, MOD + 5 * D, 1.0f};
        pg8::gemm_phase<EpiResid, pg8::StaticOrder>(lds, g, S, E, nullptr);
        SEAM(13);
    }
    if (IN(14)) {
        for (int r = gw; r < ML; r += ngw) { const float* m = MOD + (size_t)(r >> 12) * NMOD;
            norm_ada_row(out + (size_t)r * D, norm_g + 2 * D, m + 6 * D, m + 7 * D, XN + (size_t)r * D, lane); }
        SEAM(14);
    }
    if (IN(15)) {
        pg8::Gemm g{XN, WA, ML, 2 * FF, D}; pg8::StaticOrder S; S.init(ML, 2 * FF, G, bid);
        EpiSwiglu E{ACT, FF};
        pg8::gemm_phase<EpiSwiglu, pg8::StaticOrder>(lds, g, S, E, nullptr);
        SEAM(15);
    }
    if (IN(16)) {
        pg8::Gemm g{ACT, WAD, ML, D, FF}; pg8::StaticOrder S; S.init(ML, D, G, bid);
        EpiResid E{out, out, out, out, MOD + 8 * D, 0.5f};
        pg8::gemm_phase<EpiResid, pg8::StaticOrder>(lds, g, S, E, nullptr);
        SEAM(16);
    }
    if (IN(17)) {
        for (int r = gw; r < ML; r += ngw) final_norm_row(out + (size_t)r * D, a.in[28], lane);
    }
#undef IN
#undef SEAM
}
}

extern "C" void kernel_launch(void* const* d_in, const int* in_sizes, int n_in, void* d_out, int out_size, void* d_ws, size_t ws_size, hipStream_t stream) {
    static int grid = 0;
    if (grid == 0) {
        int dev = 0, cus = 0, per_cu = 0;
        if (hipGetDevice(&dev) != hipSuccess || hipDeviceGetAttribute(&cus, hipDeviceAttributeMultiprocessorCount, dev) != hipSuccess || cus <= 0) { fprintf(stderr, "kernel_launch: device query failed\n"); grid = -1; return; }
        if (hipFuncSetAttribute((const void*)mk::mk_fwd, hipFuncAttributeMaxDynamicSharedMemorySize, mk::LDS_BYTES) != hipSuccess) { fprintf(stderr, "kernel_launch: hipFuncSetAttribute failed\n"); grid = -1; return; }
        if (hipOccupancyMaxActiveBlocksPerMultiprocessor(&per_cu, (const void*)mk::mk_fwd, 512, mk::LDS_BYTES) != hipSuccess || per_cu < 1) { fprintf(stderr, "kernel_launch: occupancy query gave %d\n", per_cu); per_cu = 1; }
        (void)hipGetLastError();
        grid = cus;
    }
    if (grid < 0) return;
    if (n_in != 29 || ws_size < mk::WS_END) { fprintf(stderr, "kernel_launch: n_in %d ws %zu (need %zu)\n", n_in, ws_size, (size_t)mk::WS_END); return; }
    mk::Args a{};
    for (int i = 0; i < 29; ++i) a.in[i] = (const float*)d_in[i];
    a.out = (float*)d_out; a.ws = (unsigned char*)d_ws;
#if MK_MULTI
    for (int ph = 0; ph < mk::N_PHASES; ++ph) { a.ph_lo = ph; a.ph_hi = ph + 1; hipLaunchKernelGGL(mk::mk_fwd, dim3(grid), dim3(512), mk::LDS_BYTES, stream, a); }
#else
    a.ph_lo = 0; a.ph_hi = mk::N_PHASES;
    void* args[] = {&a};
    hipError_t e = hipLaunchCooperativeKernel((const void*)mk::mk_fwd, dim3(grid), dim3(512), args, mk::LDS_BYTES, stream);
    if (e != hipSuccess) fprintf(stderr, "kernel_launch: cooperative launch failed: %s (grid %d)\n", hipGetErrorString(e), grid);
#endif
}
```

```cpp
#include <hip/hip_runtime.h>
#include <hip/hip_cooperative_groups.h>
#include <cstdio>
#ifndef MK_MULTI
#define MK_MULTI 0
#endif
namespace pg8 {
#define PG8_LAS __attribute__((address_space(3)))
typedef unsigned short bf16_t;
typedef short bf16x8 __attribute__((ext_vector_type(8)));
typedef float f32x4 __attribute__((ext_vector_type(4)));
typedef unsigned u32x4 __attribute__((ext_vector_type(4)));
constexpr int BM = 256, BK = 64, HALF = 128, HTB = HALF * BK * 2  , STAGE_BYTES = 8 * HTB, NXCD = 8, WGM = 8;

__host__ __device__ __forceinline__ int lds_byte(int r, int c) { const int st = (r >> 4) * 2 + (c >> 5), rr = r & 15, cc = c & 31, ob = rr * 64 + cc * 2; return st * 1024 + (ob ^ (((ob >> 9) & 1) << 5)); }
__host__ __device__ __forceinline__ void stage_rc(int b, int& R, int& C) { const int st = b / 1024, sb = b % 1024, swz = sb ^ (((sb >> 9) & 1) << 5); R = (st >> 1) * 16 + swz / 64; C = (st & 1) * 32 + (swz % 64) / 2; }
__host__ __device__ __forceinline__ int perm32(int rho) { const int n = rho >> 4, i = rho & 15; return 8 * (i >> 2) + 4 * n + (i & 3); }

struct Unit { int pm, pn, kq; };
struct Gemm { const bf16_t* A; const bf16_t* Bt; int M, N, K; int ld; size_t ksub; };

struct StaticOrder {
    int nM, nN, nwg, G, c;
    __host__ __device__ void init(int M, int N, int G_, int c_) { nM = M / BM; nN = N / BM; nwg = nM * nN; G = G_; c = c_; }
    __host__ __device__ bool next(int i, Unit& u) const {
        const long L = (long)i * G + c; if (L >= nwg) return false;
        int wgid = (int)L; { const int q = nwg / NXCD, r = nwg % NXCD, xcd = wgid % NXCD, off = wgid / NXCD; wgid = (xcd < r ? xcd * (q + 1) : r * (q + 1) + (xcd - r) * q) + off; }
        const int nig = WGM * nN, gid = wgid / nig, fm = gid * WGM, gsz = (nM - fm) < WGM ? (nM - fm) : WGM;
        u.pm = fm + ((wgid % nig) % gsz); u.pn = (wgid % nig) / gsz; u.kq = 0; return true;
    }
    __device__ __forceinline__ void a_ready(const Unit&) const {}
    __device__ __forceinline__ void done(const Unit&) const {}
};
struct CountedOrder : StaticOrder {
    const unsigned* ready; unsigned need; unsigned* tmo;
    __device__ __forceinline__ void a_ready(const Unit& u) const {
        if (threadIdx.x < 64) {
            const unsigned long long t0 = __builtin_amdgcn_s_memrealtime(); unsigned polls = 0;
            while ((unsigned)__builtin_amdgcn_readfirstlane(__hip_atomic_load(ready + 64 * u.pm, __ATOMIC_RELAXED, __HIP_MEMORY_SCOPE_AGENT)) < need) {
                if ((++polls & 255u) == 0u && __builtin_amdgcn_readfirstlane(__hip_atomic_load(tmo, __ATOMIC_RELAXED, __HIP_MEMORY_SCOPE_AGENT)) != 0u) break;
                if (__builtin_amdgcn_s_memrealtime() - t0 > 2000000ull) {
                    if (threadIdx.x == 0) { unsigned expect = 0u; __hip_atomic_compare_exchange_strong(tmo + 1, &expect, 0x600u | (unsigned)(u.pm & 0xff), __ATOMIC_RELAXED, __ATOMIC_RELAXED, __HIP_MEMORY_SCOPE_AGENT); __hip_atomic_store(tmo, 1u, __ATOMIC_RELAXED, __HIP_MEMORY_SCOPE_AGENT); }
                    break; }
                __builtin_amdgcn_s_sleep(2); }
            __builtin_amdgcn_fence(__ATOMIC_ACQUIRE, "agent");
            asm volatile("s_waitcnt vmcnt(0)" ::: "memory");
        }
#if !defined(BROKEN_HOOK_NO_BARRIER)
        asm volatile("" ::: "memory"); __builtin_amdgcn_s_barrier(); asm volatile("" ::: "memory");
#endif
    }
};

__device__ __forceinline__ unsigned cvt_pk_bf16(float lo, float hi) { unsigned r; asm volatile("v_cvt_pk_bf16_f32 %0, %1, %2" : "=v"(r) : "v"(lo), "v"(hi)); return r; }
typedef float f32x2 __attribute__((ext_vector_type(2)));
__device__ __forceinline__ f32x2 gelu_pk(f32x2 v) {
    const f32x2 av = __builtin_elementwise_abs(v), d = av * 0.2316418882f + 1.0f;
    f32x2 t; t.x = __builtin_amdgcn_rcpf(d.x); t.y = __builtin_amdgcn_rcpf(d.y);
    f32x2 q = t * 0.5307027145f + (-0.7265760135f); q = q * t + 0.7107068705f; q = q * t + (-0.142248368f); q = q * t + 0.127414796f; q = q * t;
    const f32x2 s = (v * v) * (-0.72134752044f);
    f32x2 e; e.x = __builtin_amdgcn_exp2f(s.x); e.y = __builtin_amdgcn_exp2f(s.y);
    const f32x2 m = v * (q * e), r = v - m;
    f32x2 o; o.x = v.x < 0.f ? m.x : r.x; o.y = v.y < 0.f ? m.y : r.y; return o;
}

struct EpiF32 {
    static constexpr bool PERM = false, AFTER_DRAIN = false;
    float* C; int ldc; const float* bias;
    __device__ __forceinline__ void operator()(const f32x4 (&acc)[2][2][4][2], const Unit& u, int wr, int wc, int fr, int fq) const {
        const int row0 = u.pm * BM + wr * 64 + fr, col0 = u.pn * BM + wc * 32 + 4 * fq;
        f32x4 bv[2][2];
#pragma unroll
        for (int bj = 0; bj < 2; ++bj)
#pragma unroll
            for (int n = 0; n < 2; ++n) bv[bj][n] = bias ? *(const f32x4*)(bias + col0 + bj * HALF + n * 16) : (f32x4){0.f, 0.f, 0.f, 0.f};
#pragma unroll
        for (int ai = 0; ai < 2; ++ai)
#pragma unroll
            for (int m = 0; m < 4; ++m) { float* rowp = C + (size_t)(row0 + ai * HALF + m * 16) * ldc + col0;
#pragma unroll
                for (int bj = 0; bj < 2; ++bj)
#pragma unroll
                    for (int n = 0; n < 2; ++n) *(f32x4*)(rowp + bj * HALF + n * 16) = acc[ai][bj][m][n] + bv[bj][n]; }
    }
};
template <int ACT  > struct EpiBf16 {
    static constexpr bool PERM = true, AFTER_DRAIN = false;
    bf16_t* O; int ldc; const float* bias; int split_cols; size_t split_stride;
    __device__ __forceinline__ void operator()(const f32x4 (&acc)[2][2][4][2], const Unit& u, int wr, int wc, int fr, int fq) const {
        const int row0 = u.pm * BM + wr * 64 + fr; int colt = u.pn * BM; bf16_t* base = O;
        if (split_cols) { const int t = colt / split_cols; base += (size_t)t * split_stride; colt -= t * split_cols; }
        const int col0 = colt + wc * 32 + 8 * fq, bcol0 = u.pn * BM + wc * 32 + 8 * fq;
        f32x4 bv[2][2];
#pragma unroll
        for (int bj = 0; bj < 2; ++bj)
#pragma unroll
            for (int n = 0; n < 2; ++n) bv[bj][n] = bias ? *(const f32x4*)(bias + bcol0 + bj * HALF + 4 * n) : (f32x4){0.f, 0.f, 0.f, 0.f};
#pragma unroll
        for (int ai = 0; ai < 2; ++ai)
#pragma unroll
            for (int m = 0; m < 4; ++m) { bf16_t* rowp = base + (size_t)(row0 + ai * HALF + m * 16) * ldc + col0;
#pragma unroll
                for (int bj = 0; bj < 2; ++bj) { f32x4 v0 = acc[ai][bj][m][0] + bv[bj][0], v1 = acc[ai][bj][m][1] + bv[bj][1];
                    if (ACT == 1) { f32x2 a = gelu_pk((f32x2){v0[0], v0[1]}), b = gelu_pk((f32x2){v0[2], v0[3]}), c = gelu_pk((f32x2){v1[0], v1[1]}), d = gelu_pk((f32x2){v1[2], v1[3]});
                        v0 = (f32x4){a.x, a.y, b.x, b.y}; v1 = (f32x4){c.x, c.y, d.x, d.y}; }
                    if (ACT == 2) {
#pragma unroll
                        for (int j = 0; j < 4; ++j) { v0[j] = 0.5f * v0[j] * (1.0f + erff(v0[j] * 0.70710678f)); v1[j] = 0.5f * v1[j] * (1.0f + erff(v1[j] * 0.70710678f)); } }
                    u32x4 w; w.x = cvt_pk_bf16(v0[0], v0[1]); w.y = cvt_pk_bf16(v0[2], v0[3]); w.z = cvt_pk_bf16(v1[0], v1[1]); w.w = cvt_pk_bf16(v1[2], v1[3]);
                    *(u32x4*)(rowp + bj * HALF) = w; } }
    }
};

struct PanelStats {
    unsigned* xbuf;
    unsigned* cnt;
    unsigned* tmo;
    int ntn; float eps;
    unsigned code;
    __device__ __forceinline__ bool run(const f32x4 (&v)[2][2][4][2], const Unit& u, int wr, int wc, int fr, int fq, PG8_LAS unsigned char* lds, int wid, int lane) const {
        typedef float f32x2v __attribute__((ext_vector_type(2)));
        PG8_LAS f32x2v* P = (PG8_LAS f32x2v*)lds;
        PG8_LAS f32x2v* S = (PG8_LAS f32x2v*)(lds + 8192);
        PG8_LAS unsigned* flag = (PG8_LAS unsigned*)(lds + 8192 + 2048);
#pragma unroll
        for (int ai = 0; ai < 2; ++ai)
#pragma unroll
            for (int m = 0; m < 4; ++m) {
                float s = 0.f;
#pragma unroll
                for (int bj = 0; bj < 2; ++bj)
#pragma unroll
                    for (int n = 0; n < 2; ++n) { const f32x4 x = v[ai][bj][m][n]; s += (x[0] + x[1]) + (x[2] + x[3]); }
                s += __shfl_xor(s, 16); s += __shfl_xor(s, 32);
                const float mw = s * (1.0f / 64.0f); float q = 0.f;
#pragma unroll
                for (int bj = 0; bj < 2; ++bj)
#pragma unroll
                    for (int n = 0; n < 2; ++n) { const f32x4 d = v[ai][bj][m][n] - mw; q += (d[0] * d[0] + d[1] * d[1]) + (d[2] * d[2] + d[3] * d[3]); }
                q += __shfl_xor(q, 16); q += __shfl_xor(q, 32);
                if (fq == 0) P[(ai * HALF + wr * 64 + m * 16 + fr) * 4 + wc] = (f32x2v){mw, q};
            }
        asm volatile("s_waitcnt lgkmcnt(0)" ::: "memory"); __builtin_amdgcn_s_barrier(); asm volatile("" ::: "memory");
#if defined(BROKEN_NO_WAIT)
        if (blockIdx.x >= 64) { const long long t0 = clock64(); while (clock64() - t0 < 60000) __builtin_amdgcn_s_sleep(8); }
#endif
        const int row = wid * 32 + (lane & 31);
        if (lane < 32) {
            const f32x2v a = P[row * 4 + 0], b = P[row * 4 + 1], c = P[row * 4 + 2], d = P[row * 4 + 3];
            const float mt = (a.x + b.x + c.x + d.x) * 0.25f;
            const float da = a.x - mt, db = b.x - mt, dc = c.x - mt, dd = d.x - mt;
            const float m2 = (a.y + b.y) + (c.y + d.y) + 64.0f * ((da * da + db * db) + (dc * dc + dd * dd));
            unsigned long long* slot = (unsigned long long*)xbuf + ((size_t)(u.pm * BM + row) * 4 + u.pn);
            __hip_atomic_store(slot, ((unsigned long long)__float_as_uint(m2) << 32) | __float_as_uint(mt), __ATOMIC_RELAXED, __HIP_MEMORY_SCOPE_AGENT);
        }
        asm volatile("s_waitcnt vmcnt(0)" ::: "memory");
        if (lane == 0) __hip_atomic_fetch_add(cnt + 64 * u.pm, 1u, __ATOMIC_RELAXED, __HIP_MEMORY_SCOPE_AGENT);
        if (wid == 0) {
            bool dead = false; const unsigned long long t0 = __builtin_amdgcn_s_memrealtime(); const unsigned want = 8u * (unsigned)ntn;
            for (;;) {
#if defined(BROKEN_NO_WAIT)
                break;
#endif
                if ((unsigned)__builtin_amdgcn_readfirstlane(__hip_atomic_load(cnt + 64 * u.pm, __ATOMIC_RELAXED, __HIP_MEMORY_SCOPE_AGENT)) >= want) break;
                if (__builtin_amdgcn_s_memrealtime() - t0 > 2000000ull) {
                    if (lane == 0) { unsigned expect = 0u; __hip_atomic_compare_exchange_strong(tmo + 1, &expect, code | (unsigned)(u.pm & 0xff), __ATOMIC_RELAXED, __ATOMIC_RELAXED, __HIP_MEMORY_SCOPE_AGENT);
                                     __hip_atomic_store(tmo, 1u, __ATOMIC_RELAXED, __HIP_MEMORY_SCOPE_AGENT); }
                    dead = true; break; }
                __builtin_amdgcn_s_sleep(2);
            }
            __builtin_amdgcn_fence(__ATOMIC_ACQUIRE, "agent");
            if (lane == 0) flag[0] = dead ? 1u : 0u;
        }
        asm volatile("s_waitcnt vmcnt(0) lgkmcnt(0)" ::: "memory"); __builtin_amdgcn_s_barrier(); asm volatile("" ::: "memory");
        const bool bad = flag[0] != 0u;
        if (lane < 32) {
            const unsigned long long* slot = (const unsigned long long*)xbuf + (size_t)(u.pm * BM + row) * 4; float mt[4], m2[4]; float ms = 0.f;
#pragma unroll
            for (int t = 0; t < 4; ++t) { if (t < ntn) { const unsigned long long w = __hip_atomic_load(slot + t, __ATOMIC_RELAXED, __HIP_MEMORY_SCOPE_AGENT); mt[t] = __uint_as_float((unsigned)w); m2[t] = __uint_as_float((unsigned)(w >> 32)); } else { mt[t] = 0.f; m2[t] = 0.f; } ms += mt[t]; }
            const float mean = ms / (float)ntn; float q = 0.f;
#pragma unroll
            for (int t = 0; t < 4; ++t) if (t < ntn) { const float dm = mt[t] - mean; q += m2[t] + 256.0f * dm * dm; }
            S[row] = (f32x2v){mean, 1.0f / sqrtf(q / (256.0f * (float)ntn) + eps)};
        }
        asm volatile("s_waitcnt lgkmcnt(0)" ::: "memory"); __builtin_amdgcn_s_barrier(); asm volatile("" ::: "memory");
        return bad;
    }
};
struct EpiLnRes {
    static constexpr bool PERM = false, AFTER_DRAIN = true;
    const float* base; float* out; int ldc; const float* bias; PanelStats st; unsigned poison;
    __device__ __forceinline__ void refuse(size_t i0, size_t stride, int M, int N) const { const float q = __builtin_nanf(""); for (size_t i = i0; i < (size_t)M * N; i += stride) out[(i / N) * ldc + i % N] = q;
        if (i0 == 0) { unsigned expect = 0u; __hip_atomic_compare_exchange_strong(st.tmo + 1, &expect, 0x7f0u, __ATOMIC_RELAXED, __ATOMIC_RELAXED, __HIP_MEMORY_SCOPE_AGENT); __hip_atomic_store(st.tmo, 1u, __ATOMIC_RELAXED, __HIP_MEMORY_SCOPE_AGENT); } }
    __device__ __forceinline__ void fused(f32x4 (&acc)[2][2][4][2], const Unit& u, int wr, int wc, int fr, int fq, PG8_LAS unsigned char* lds, int wid, int lane) const {
        typedef float f32x2v __attribute__((ext_vector_type(2)));
        const PG8_LAS f32x2v* S = (const PG8_LAS f32x2v*)(lds + 8192);
        const int col0 = u.pn * BM + wc * 32 + 4 * fq;
#pragma unroll
        for (int bj = 0; bj < 2; ++bj)
#pragma unroll
            for (int n = 0; n < 2; ++n) { const f32x4 bv = bias ? *(const f32x4*)(bias + col0 + bj * HALF + n * 16) : (f32x4){0.f, 0.f, 0.f, 0.f};
#pragma unroll
                for (int ai = 0; ai < 2; ++ai)
#pragma unroll
                    for (int m = 0; m < 4; ++m) acc[ai][bj][m][n] += bv; }
        const bool bad = st.run(acc, u, wr, wc, fr, fq, lds, wid, lane) || poison != 0u;
        const float qnan = __builtin_nanf("");
#pragma unroll
        for (int ai = 0; ai < 2; ++ai)
#pragma unroll
            for (int m = 0; m < 4; ++m) { const int r = ai * HALF + wr * 64 + m * 16 + fr; const f32x2v sr = S[r]; const size_t off = (size_t)(u.pm * BM + r) * ldc + col0;
#pragma unroll
                for (int bj = 0; bj < 2; ++bj)
#pragma unroll
                    for (int n = 0; n < 2; ++n) { const f32x4 bs = *(const f32x4*)(base + off + bj * HALF + n * 16); f32x4 o = bs + (acc[ai][bj][m][n] - sr.x) * sr.y;
                        if (bad) o = (f32x4){qnan, qnan, qnan, qnan}; *(f32x4*)(out + off + bj * HALF + n * 16) = o; }
                asm volatile("" ::: "memory"); }
    }
};
struct EpiLnResLn {
    static constexpr bool PERM = false, AFTER_DRAIN = true;
    const float* base; float* out; bf16_t* xn; int ldc; const float* bias; PanelStats st1, st2; unsigned poison;
    __device__ __forceinline__ void refuse(size_t i0, size_t stride, int M, int N) const { const float q = __builtin_nanf(""); for (size_t i = i0; i < (size_t)M * N; i += stride) { const size_t o = (i / N) * ldc + i % N; out[o] = q; xn[o] = (bf16_t)0x7fc0u; }
        if (i0 == 0) { unsigned expect = 0u; __hip_atomic_compare_exchange_strong(st1.tmo + 1, &expect, 0x7f0u, __ATOMIC_RELAXED, __ATOMIC_RELAXED, __HIP_MEMORY_SCOPE_AGENT); __hip_atomic_store(st1.tmo, 1u, __ATOMIC_RELAXED, __HIP_MEMORY_SCOPE_AGENT); } }
    __device__ __forceinline__ void fused(f32x4 (&acc)[2][2][4][2], const Unit& u, int wr, int wc, int fr, int fq, PG8_LAS unsigned char* lds, int wid, int lane) const {
        typedef float f32x2v __attribute__((ext_vector_type(2))); typedef unsigned u32x2v __attribute__((ext_vector_type(2)));
        const PG8_LAS f32x2v* S = (const PG8_LAS f32x2v*)(lds + 8192);
        const int col0 = u.pn * BM + wc * 32 + 4 * fq;
#pragma unroll
        for (int bj = 0; bj < 2; ++bj)
#pragma unroll
            for (int n = 0; n < 2; ++n) { const f32x4 bv = bias ? *(const f32x4*)(bias + col0 + bj * HALF + n * 16) : (f32x4){0.f, 0.f, 0.f, 0.f};
#pragma unroll
                for (int ai = 0; ai < 2; ++ai)
#pragma unroll
                    for (int m = 0; m < 4; ++m) acc[ai][bj][m][n] += bv; }
        bool bad = st1.run(acc, u, wr, wc, fr, fq, lds, wid, lane) || poison != 0u;
        const float qnan = __builtin_nanf("");
#pragma unroll
        for (int ai = 0; ai < 2; ++ai)
#pragma unroll
            for (int m = 0; m < 4; ++m) { const int r = ai * HALF + wr * 64 + m * 16 + fr; const f32x2v sr = S[r]; const size_t off = (size_t)(u.pm * BM + r) * ldc + col0;
#pragma unroll
                for (int bj = 0; bj < 2; ++bj)
#pragma unroll
                    for (int n = 0; n < 2; ++n) { const f32x4 bs = *(const f32x4*)(base + off + bj * HALF + n * 16); acc[ai][bj][m][n] = bs + (acc[ai][bj][m][n] - sr.x) * sr.y; }
                asm volatile("" : "+v"(acc[ai][0][m][0]), "+v"(acc[ai][0][m][1]), "+v"(acc[ai][1][m][0]), "+v"(acc[ai][1][m][1]));
                if (m & 1) asm volatile("" ::: "memory"); }
        const bool bad1 = bad;
        bad = st2.run(acc, u, wr, wc, fr, fq, lds, wid, lane) || bad;
#pragma unroll
        for (int ai = 0; ai < 2; ++ai)
#pragma unroll
            for (int m = 0; m < 4; ++m) { const int r = ai * HALF + wr * 64 + m * 16 + fr; const f32x2v sr = S[r]; const size_t off = (size_t)(u.pm * BM + r) * ldc + col0;
#pragma unroll
                for (int bj = 0; bj < 2; ++bj)
#pragma unroll
                    for (int n = 0; n < 2; ++n) { const f32x4 x1 = acc[ai][bj][m][n]; *(f32x4*)(out + off + bj * HALF + n * 16) = bad1 ? (f32x4){qnan, qnan, qnan, qnan} : x1;
                        const f32x4 o = (x1 - sr.x) * sr.y; u32x2v w; w.x = cvt_pk_bf16(o[0], o[1]); w.y = cvt_pk_bf16(o[2], o[3]);
                        if (bad) { w.x = 0x7fc07fc0u; w.y = 0x7fc07fc0u; } *(u32x2v*)(xn + off + bj * HALF + n * 16) = w; }
                asm volatile("" ::: "memory"); }
    }
};

template <class Epi, class Sched, bool STAMP = false>
__device__ __forceinline__ void gemm_phase(PG8_LAS unsigned char* lds, const Gemm g, const Sched& S, const Epi& E, unsigned long long* stamps) {
    const int tid = threadIdx.x, wid = __builtin_amdgcn_readfirstlane(tid >> 6), lane = tid & 63, wr = wid >> 2, wc = wid & 3, fr = lane & 15, fq = lane >> 4;
    const int K = g.K, nt = K / BK, LD = g.ld;
    int ts_lo = 0, ts_hi = 0, nts = 0; const unsigned long long rt_entry = STAMP ? (unsigned long long)wall_clock64() : 0ull;
#define PG8_STAMP() do { if (STAMP && wid == 0 && nts < 64) { const unsigned long long _c = (unsigned long long)clock64(); \
        ts_lo = (lane == nts) ? (int)(unsigned)_c : ts_lo; ts_hi = (lane == nts) ? (int)(unsigned)(_c >> 32) : ts_hi; ++nts; } } while (0)
    PG8_STAMP();
    unsigned voffA[2], voffB[2];
#pragma unroll
    for (int i = 0; i < 2; ++i) { int R, C; stage_rc(tid * 16 + i * 8192, R, C); const int Rb = Epi::PERM ? ((R & ~31) + perm32(R & 31)) : R;
        voffA[i] = (unsigned)(R * LD + C) * 2u; voffB[i] = (unsigned)(Rb * LD + C) * 2u; }
    const size_t kstep = (size_t)(BK * 2);
    const size_t hstep = (size_t)HALF * LD * 2;
    const size_t tstep = 2 * hstep;
    const unsigned ldsw = (unsigned)wid * 1024u;
    const int aoff = lds_byte(wr * 64 + fr, fq * 8), boff = lds_byte(wc * 32 + fr, fq * 8);
#define PG8_SA(b, h) (((b) * 2 + (h)) * HTB)
#define PG8_SB(b, h) ((4 + (b) * 2 + (h)) * HTB)
#define PG8_STAGE(bufoff, gbase, voff) do { _Pragma("unroll") for (int _i = 0; _i < 2; ++_i) \
        __builtin_amdgcn_global_load_lds((const unsigned*)((const char*)(gbase) + (voff)[_i]), (PG8_LAS unsigned*)(lds + (bufoff) + ldsw + _i * 8192), 16, 0, 0); } while (0)
#define PG8_LDA(dst, b, h) do { _Pragma("unroll") for (int m = 0; m < 4; ++m) _Pragma("unroll") for (int k = 0; k < 2; ++k) dst[m][k] = *(const PG8_LAS bf16x8*)(lds + PG8_SA(b, h) + aoff + m * 2048 + k * 1024); } while (0)
#define PG8_LDB(dst, b, h) do { _Pragma("unroll") for (int n = 0; n < 2; ++n) _Pragma("unroll") for (int k = 0; k < 2; ++k) dst[n][k] = *(const PG8_LAS bf16x8*)(lds + PG8_SB(b, h) + boff + n * 2048 + k * 1024); } while (0)
#define PG8_MMA(ai, bj, At, Bt) do { __builtin_amdgcn_s_setprio(1); _Pragma("unroll") for (int m = 0; m < 4; ++m) _Pragma("unroll") for (int n = 0; n < 2; ++n) _Pragma("unroll") for (int k = 0; k < 2; ++k) \
        acc[ai][bj][m][n] = __builtin_amdgcn_mfma_f32_16x16x32_bf16(Bt[n][k], At[m][k], acc[ai][bj][m][n], 0, 0, 0); __builtin_amdgcn_s_setprio(0); } while (0)
#define PG8_WAIT_V(n) asm volatile("s_waitcnt vmcnt(" #n ")" ::: "memory")
#define PG8_WAIT_L(n) asm volatile("s_waitcnt lgkmcnt(" #n ")" ::: "memory")
#define PG8_BAR __builtin_amdgcn_s_barrier()
#define PG8_SCHED __builtin_amdgcn_sched_barrier(0)
    Unit cur, nxt; int ui = 0;
    if (!S.next(0, cur)) return;
    f32x4 acc[2][2][4][2];
#pragma unroll
    for (int a = 0; a < 2; ++a)
#pragma unroll
        for (int b = 0; b < 2; ++b)
#pragma unroll
            for (int m = 0; m < 4; ++m)
#pragma unroll
                for (int n = 0; n < 2; ++n) acc[a][b][m][n] = (f32x4){0.f, 0.f, 0.f, 0.f};
    bf16x8 At[4][2], B0[2][2], B1[2][2];
    const char* cA = (const char*)g.A + (size_t)cur.pm * tstep + (size_t)cur.kq * g.ksub; const char* cB = (const char*)g.Bt + (size_t)cur.pn * tstep + (size_t)cur.kq * g.ksub;
    S.a_ready(cur);
    PG8_STAGE(PG8_SB(0, 0), cB, voffB); PG8_STAGE(PG8_SA(0, 0), cA, voffA); PG8_STAGE(PG8_SB(0, 1), cB + hstep, voffB); PG8_STAGE(PG8_SA(0, 1), cA + hstep, voffA);
    if (wr == 1) PG8_BAR;
    PG8_WAIT_V(4); PG8_BAR;
    PG8_STAGE(PG8_SB(1, 0), cB + kstep, voffB); PG8_STAGE(PG8_SA(1, 0), cA + kstep, voffA); PG8_STAGE(PG8_SB(1, 1), cB + hstep + kstep, voffB);
    PG8_WAIT_V(6); PG8_BAR;
    PG8_STAMP();
    for (;;) {
        const bool has_next = S.next(ui + 1, nxt);
        const char* nA = has_next ? (const char*)g.A + (size_t)nxt.pm * tstep + (size_t)nxt.kq * g.ksub : cA; const char* nB = has_next ? (const char*)g.Bt + (size_t)nxt.pn * tstep + (size_t)nxt.kq * g.ksub : cB;
        for (int t = 0; t < nt; t += 2) {
            const bool last = (t == nt - 2);
            const char* a1 = cA + (size_t)(t + 1) * kstep;
            const char* a2 = last ? nA : cA + (size_t)(t + 2) * kstep; const char* b2 = last ? nB : cB + (size_t)(t + 2) * kstep;
            const char* a3 = a2 + kstep; const char* b3 = b2 + kstep;
            if (last && has_next) S.a_ready(nxt);
            PG8_LDB(B0, 0, 0); PG8_SCHED; PG8_LDA(At, 0, 0); PG8_STAGE(PG8_SA(1, 1), a1 + hstep, voffA);
            PG8_WAIT_L(8); PG8_BAR; PG8_WAIT_L(0); PG8_MMA(0, 0, At, B0); PG8_BAR; PG8_SCHED;
            PG8_LDB(B1, 0, 1); PG8_STAGE(PG8_SB(0, 0), b2, voffB);
            PG8_BAR; PG8_WAIT_L(0); PG8_MMA(0, 1, At, B1); PG8_BAR;
            PG8_LDA(At, 0, 1); PG8_STAGE(PG8_SA(0, 0), a2, voffA);
            PG8_BAR; PG8_WAIT_L(0); PG8_MMA(1, 0, At, B0); PG8_BAR; PG8_SCHED;
            PG8_STAGE(PG8_SB(0, 1), b2 + hstep, voffB);
            PG8_WAIT_V(6); PG8_BAR; PG8_MMA(1, 1, At, B1); PG8_BAR;
            PG8_LDB(B0, 1, 0); PG8_SCHED; PG8_LDA(At, 1, 0); PG8_STAGE(PG8_SA(0, 1), a2 + hstep, voffA);
            PG8_WAIT_L(8); PG8_BAR; PG8_WAIT_L(0); PG8_MMA(0, 0, At, B0); PG8_BAR; PG8_SCHED;
            PG8_LDB(B1, 1, 1); PG8_STAGE(PG8_SB(1, 0), b3, voffB);
            PG8_BAR; PG8_WAIT_L(0); PG8_MMA(0, 1, At, B1); PG8_BAR;
            PG8_LDA(At, 1, 1); PG8_STAGE(PG8_SA(1, 0), a3, voffA);
            PG8_BAR; PG8_WAIT_L(0); PG8_MMA(1, 0, At, B0); PG8_BAR; PG8_SCHED;
            PG8_STAGE(PG8_SB(1, 1), b3 + hstep, voffB);
            PG8_WAIT_V(6); PG8_BAR; PG8_MMA(1, 1, At, B1); PG8_BAR;
        }
        PG8_STAMP();
        if constexpr (!Epi::AFTER_DRAIN) { E(acc, cur, wr, wc, fr, fq); S.done(cur); }
        PG8_STAMP();
        if (!has_next) break;
#pragma unroll
        for (int a = 0; a < 2; ++a)
#pragma unroll
            for (int b = 0; b < 2; ++b)
#pragma unroll
                for (int m = 0; m < 4; ++m)
#pragma unroll
                    for (int n = 0; n < 2; ++n) acc[a][b][m][n] = (f32x4){0.f, 0.f, 0.f, 0.f};
        cur = nxt; cA = nA; cB = nB; ++ui;
    }
    PG8_WAIT_V(0);
    if (wr == 0) PG8_BAR;
    PG8_BAR;
    if constexpr (Epi::AFTER_DRAIN) { E.fused(acc, cur, wr, wc, fr, fq, lds, wid, lane); S.done(cur); }
    PG8_STAMP();
    if (STAMP && wid == 0) { stamps[lane] = lane < nts ? (((unsigned long long)(unsigned)ts_hi << 32) | (unsigned)ts_lo) : 0ull;
        if (lane == 62) stamps[62] = rt_entry; if (lane == 63) stamps[63] = (unsigned long long)wall_clock64(); }
#undef PG8_STAMP
#undef PG8_SA
#undef PG8_SB
#undef PG8_STAGE
#undef PG8_LDA
#undef PG8_LDB
#undef PG8_MMA
#undef PG8_WAIT_V
#undef PG8_WAIT_L
#undef PG8_BAR
#undef PG8_SCHED
}
}
#define XB_TMO      128
#define XB_XCNT(j)  (256  + 64 * (j))
#define XB_XSUB(j)  (1280 + 64 * (j))
#define XB_XGEN(j)  (2304 + 64 * (j))
#define XB_TOP      3328
#define XB_TOPGEN   3392
#define XCD_BAR_WORDS 3456
#define XB_SPIN_CAP (1u << 18)
#define LAS __attribute__((address_space(3)))

__device__ __forceinline__ unsigned xb_ld(unsigned* p)              { return __hip_atomic_load(p, __ATOMIC_RELAXED, __HIP_MEMORY_SCOPE_AGENT); }
__device__ __forceinline__ unsigned xb_add(unsigned* p, unsigned v) { return __hip_atomic_fetch_add(p, v, __ATOMIC_RELAXED, __HIP_MEMORY_SCOPE_AGENT); }
__device__ __forceinline__ unsigned xb_xcc_id() { return (unsigned)__builtin_amdgcn_s_getreg((3 << 11) | 20) & 0xFu; }
#define XB_SPIN(cond, bar) do { unsigned _sp = 0; while (cond) { __builtin_amdgcn_s_sleep(1); \
    if ((++_sp & 255u) == 0u) { if (xb_ld(&(bar)[XB_TMO])) break; if (_sp > XB_SPIN_CAP) { atomicAdd(&(bar)[XB_TMO], 1u); break; } } } } while (0)

struct XcdBarrier {
    unsigned* bar; unsigned x;
    volatile LAS unsigned* st;
};

__device__ __forceinline__ XcdBarrier xcd_barrier_post(unsigned* bar, volatile LAS unsigned* st) {
    XcdBarrier b; b.bar = bar; b.x = xb_xcc_id(); b.st = st;
    if (threadIdx.x == 0) (void)xb_add(&bar[XB_XCNT(b.x)], 1u);
    return b;
}
__device__ __forceinline__ void xcd_barrier_complete(unsigned* bar, unsigned x, unsigned& nloc, unsigned& nx) {
    const unsigned G = gridDim.x * gridDim.y * gridDim.z;
    unsigned sum, cnt, mine, sp = 0u;
    for (;;) {
        sum = 0u; cnt = 0u; mine = 0u;
#pragma unroll
        for (unsigned j = 0; j < 16; ++j) { const unsigned c = xb_ld(&bar[XB_XCNT(j)]); sum += c; cnt += (c > 0u) ? 1u : 0u; mine = (j == x) ? c : mine; }
        if (sum == G) break;
        __builtin_amdgcn_s_sleep(1);
        if ((++sp & 255u) == 0u) { if (xb_ld(&bar[XB_TMO])) break; if (sp > XB_SPIN_CAP) { atomicAdd(&bar[XB_TMO], 1u); break; } }
    }
    nloc = mine > 0u ? mine : 1u; nx = cnt > 0u ? cnt : 1u;
}

__device__ __forceinline__ void xcd_barrier(const XcdBarrier& b) {
    asm volatile("s_waitcnt vmcnt(0)" ::: "memory");
    __syncthreads();
    if (threadIdx.x == 0) {
        unsigned* bar = b.bar;
        __builtin_amdgcn_s_waitcnt(0);
        unsigned nloc = b.st[0], nx = b.st[1];
        if (nloc == 0u) { xcd_barrier_complete(bar, b.x, nloc, nx); b.st[0] = nloc; b.st[1] = nx; }
        const unsigned old = xb_add(&bar[XB_XSUB(b.x)], 1u);
        const unsigned gen = old / nloc;
        if (old + 1u == (gen + 1u) * nloc) {
            __builtin_amdgcn_fence(__ATOMIC_RELEASE, "agent");
            asm volatile("s_waitcnt vmcnt(0)" ::: "memory");
            const unsigned og = xb_add(&bar[XB_TOP], 1u);
            const unsigned tg = og / nx;
            if (og + 1u == (tg + 1u) * nx) xb_add(&bar[XB_TOPGEN], 1u);
            else XB_SPIN(xb_ld(&bar[XB_TOPGEN]) == tg, bar);
            __builtin_amdgcn_fence(__ATOMIC_ACQUIRE, "agent");
            xb_add(&bar[XB_XGEN(b.x)], 1u);
            asm volatile("s_waitcnt vmcnt(0)" ::: "memory");
        } else {
            XB_SPIN(xb_ld(&bar[XB_XGEN(b.x)]) == gen, bar);
            __builtin_amdgcn_fence(__ATOMIC_ACQUIRE, "agent");
            asm volatile("s_waitcnt vmcnt(0)" ::: "memory");
        }
    }
    __syncthreads();
}


namespace cg = cooperative_groups;
namespace mk {
using pg8::bf16_t; using pg8::f32x4; using pg8::u32x4; using pg8::Unit;
typedef unsigned u32x2 __attribute__((ext_vector_type(2)));
typedef float f32x2 __attribute__((ext_vector_type(2)));
#define LDS_WAIT() asm volatile("s_waitcnt lgkmcnt(0)" ::: "memory")

constexpr int D = 2048, FF = 5632, ML = 16384, MC = 1024, MT = 17408, SEQ = 4096, CTXL = 256;
constexpr int NIN = 11520, NMOD = 18432;
constexpr int NITEM = 4352;

constexpr size_t al(size_t x) { return (x + 255) & ~(size_t)255; }
constexpr size_t OFF_MOD  = 0;
constexpr size_t OFF_H2   = al(OFF_MOD + (size_t)5 * NMOD * 4);
constexpr size_t OFF_HC   = al(OFF_H2 + (size_t)4096 * 64 * 4);
constexpr size_t OFF_ABF  = al(OFF_HC + (size_t)MC * D * 4);
constexpr size_t OFF_G    = al(OFF_ABF + (size_t)MT * 32 * 4);
constexpr size_t OFF_BETA = al(OFF_G + (size_t)MT * 16 * 4);
constexpr size_t OFF_XN   = al(OFF_BETA + (size_t)MT * 16 * 4);
constexpr size_t OFF_WA   = al(OFF_XN + (size_t)MT * D * 2);
constexpr size_t OFF_WA_D = OFF_WA + (size_t)2 * FF * D * 2;
constexpr size_t OFF_WB   = al(OFF_WA_D + (size_t)D * FF * 2);
constexpr size_t OFF_BIG  = al(OFF_WB + (size_t)NIN * D * 2);
constexpr size_t SZ_PH    = (size_t)ML * 3072 * 2;
constexpr size_t SZ_PQKV  = (size_t)MT * 3072 * 2;
constexpr size_t OFF_PH   = OFF_BIG;
constexpr size_t OFF_PQKV = OFF_BIG + SZ_PH;
constexpr size_t OFF_PB   = al(OFF_PQKV + SZ_PQKV);
constexpr size_t OFF_O    = al(OFF_PB + (size_t)ML * 5120 * 2);
constexpr size_t OFF_OG   = al(OFF_O + (size_t)2 * ML * 1024 * 2);
constexpr size_t OFF_BAR  = al(OFF_OG + (size_t)ML * 1024 * 2);
constexpr size_t WS_END   = al(OFF_BAR + (size_t)XCD_BAR_WORDS * 4);
constexpr size_t OFF_ACT  = OFF_BIG;
constexpr size_t OFF_U    = OFF_XN;
constexpr size_t OFF_W    = OFF_U + (size_t)NITEM * 64 * 128 * 2;
constexpr size_t OFF_QK   = OFF_W + (size_t)NITEM * 64 * 128 * 2;
constexpr size_t OFF_GC   = OFF_QK + (size_t)NITEM * 64 * 64 * 2;
constexpr size_t OFF_KFS  = OFF_XN;
constexpr size_t OFF_HYT  = OFF_PH;
constexpr size_t OFF_Z2   = OFF_PQKV + (size_t)ML * 1024 * 2;
constexpr size_t OFF_TMP  = OFF_BIG + (size_t)ML * 1024 * 2;
constexpr size_t OFF_Z2T  = OFF_PQKV;
constexpr size_t OFF_WHY  = OFF_WB;
constexpr size_t OFF_WGD  = OFF_WHY + (size_t)D * 1024 * 2;
constexpr size_t OFF_WO   = OFF_WGD + (size_t)D * 1024 * 2;
static_assert(OFF_GC + (size_t)NITEM * 128 * 4 <= OFF_BIG, "UWQK overflow");
static_assert(OFF_KFS + (size_t)2 * 1024 * 8192 * 8 <= OFF_WB, "KFS overflow");
static_assert((size_t)MT * FF * 2 <= OFF_PB - OFF_BIG, "ACT overflow");
static_assert(OFF_TMP + (size_t)ML * D * 4 <= OFF_PB, "TMP overflow");
static_assert(OFF_WO + (size_t)D * D * 2 <= OFF_BIG, "WB overflow");

constexpr int LDS_BYTES = 147456;

struct Args { const float* in[29]; float* out; unsigned char* ws; int ph_lo, ph_hi, sub, pad; };

__device__ __forceinline__ float wave_sum(float v) {
#pragma unroll
    for (int o = 1; o < 64; o <<= 1) v += __shfl_xor(v, o);
    return v;
}
__device__ __forceinline__ float bf2f(unsigned short b) { return __uint_as_float((unsigned)b << 16); }
__device__ __forceinline__ float bflo(unsigned w) { return __uint_as_float(w << 16); }
__device__ __forceinline__ float bfhi(unsigned w) { return __uint_as_float(w & 0xffff0000u); }
typedef __bf16 bf16x2_t __attribute__((ext_vector_type(2)));
__device__ __forceinline__ unsigned pk2(float lo, float hi) { return __builtin_bit_cast(unsigned, __builtin_convertvector((f32x2){lo, hi}, bf16x2_t)); }
__device__ __forceinline__ float silu_f(float x) { return x * __builtin_amdgcn_rcpf(1.f + __expf(-x)); }
__device__ __forceinline__ float sigm_f(float x) { return __builtin_amdgcn_rcpf(1.f + __expf(-x)); }

constexpr int CONV_SCR = 64 * 66 * 4;
__device__ __forceinline__ void conv_item(const float* __restrict__ W, int K, int Nsrc, bf16_t* __restrict__ WT, int kb, int n0dst, int n0src, int nvalid, float* scr, int lane) {
    const int k0 = 64 * kb, r4 = lane >> 4, c4 = (lane & 15) * 4;
    f32x4 v[16];
#pragma unroll
    for (int i = 0; i < 16; ++i) { v[i] = (f32x4){0.f, 0.f, 0.f, 0.f}; if (c4 < nvalid) v[i] = *(const f32x4*)(W + (size_t)(k0 + 4 * i + r4) * Nsrc + n0src + c4); }
#pragma unroll
    for (int i = 0; i < 16; ++i) { float* d = scr + (4 * i + r4) * 66 + c4; *(f32x2*)d = (f32x2){v[i].x, v[i].y}; *(f32x2*)(d + 2) = (f32x2){v[i].z, v[i].w}; }
    LDS_WAIT();
    const int c = lane & 7;
#pragma unroll
    for (int j = 0; j < 8; ++j) { const int n = (lane >> 3) + 8 * j; const float* s = scr + (8 * c) * 66 + n;
        u32x4 o; o.x = pk2(s[0], s[66]); o.y = pk2(s[132], s[198]); o.z = pk2(s[264], s[330]); o.w = pk2(s[396], s[462]);
        *(u32x4*)(WT + (size_t)(n0dst + n) * K + k0 + 8 * c) = o; }
    LDS_WAIT();
}
__device__ __forceinline__ int colmap(int mode, int n0, int& nvalid) {
    nvalid = 64;
    if (mode == 0) return n0;
    if (mode == 1) { const int pn = n0 >> 8, half = (n0 >> 7) & 1; return half * FF + pn * 128 + (n0 & 127); }
    if (n0 < 7168) return n0;
    if (n0 == 7168) { nvalid = 32; return 7168; }
    if (n0 < 7424) { nvalid = 0; return 0; }
    return 7200 + (n0 - 7424);
}
__device__ __forceinline__ void conv_matrix(const float* W, int K, int Nsrc, bf16_t* WT, int Ndst, int mode, int it, float* scr, int lane) {
    const int nblk = Ndst / 64, kb = it / nblk, nb = it % nblk; int nvalid;
    const int n0src = colmap(mode, nb * 64, nvalid);
    conv_item(W, K, Nsrc, WT, kb, nb * 64, n0src, nvalid, scr, lane);
}

__device__ __forceinline__ void norm_ada_row(const float* __restrict__ src, const float* __restrict__ gain, const float* __restrict__ shift, const float* __restrict__ scale, bf16_t* __restrict__ dst, int lane) {
    f32x4 v[8]; float ss = 0.f;
#pragma unroll
    for (int j = 0; j < 8; ++j) { v[j] = *(const f32x4*)(src + 4 * lane + 256 * j); ss += (v[j].x * v[j].x + v[j].y * v[j].y) + (v[j].z * v[j].z + v[j].w * v[j].w); }
    ss = wave_sum(ss);
    const float rstd = rsqrtf(ss * (1.f / 2048.f) + 1e-6f);
#pragma unroll
    for (int j = 0; j < 8; ++j) {
        const f32x4 g = *(const f32x4*)(gain + 4 * lane + 256 * j), sh = *(const f32x4*)(shift + 4 * lane + 256 * j), sc = *(const f32x4*)(scale + 4 * lane + 256 * j);
        const f32x4 y = (v[j] * rstd) * g; const f32x4 o = y * (sc + 1.f) + sh;
        u32x2 w; w.x = pk2(o.x, o.y); w.y = pk2(o.z, o.w);
        *(u32x2*)(dst + 4 * lane + 256 * j) = w; }
}
__device__ __forceinline__ void norm_ada_row_ctx(const float* __restrict__ src, const float* __restrict__ part, const float* __restrict__ gain, const float* __restrict__ shift, const float* __restrict__ scale, bf16_t* __restrict__ dst, int lane) {
    f32x4 v[8]; float ss = 0.f;
#pragma unroll
    for (int j = 0; j < 8; ++j) { const int o = 4 * lane + 256 * j;
        v[j] = *(const f32x4*)(src + o) + ((*(const f32x4*)(part + o) + *(const f32x4*)(part + (size_t)MC * D + o)) + (*(const f32x4*)(part + (size_t)2 * MC * D + o) + *(const f32x4*)(part + (size_t)3 * MC * D + o)));
        ss += (v[j].x * v[j].x + v[j].y * v[j].y) + (v[j].z * v[j].z + v[j].w * v[j].w); }
    ss = wave_sum(ss);
    const float rstd = rsqrtf(ss * (1.f / 2048.f) + 1e-6f);
#pragma unroll
    for (int j = 0; j < 8; ++j) {
        const f32x4 g = *(const f32x4*)(gain + 4 * lane + 256 * j), sh = *(const f32x4*)(shift + 4 * lane + 256 * j), sc = *(const f32x4*)(scale + 4 * lane + 256 * j);
        const f32x4 y = (v[j] * rstd) * g; const f32x4 o = y * (sc + 1.f) + sh;
        u32x2 w; w.x = pk2(o.x, o.y); w.y = pk2(o.z, o.w);
        *(u32x2*)(dst + 4 * lane + 256 * j) = w; }
}
__device__ __forceinline__ void final_norm_row(float* __restrict__ row, const float* __restrict__ gain, int lane) {
    f32x4 v[8]; float ss = 0.f;
#pragma unroll
    for (int j = 0; j < 8; ++j) { v[j] = *(const f32x4*)(row + 4 * lane + 256 * j); ss += (v[j].x * v[j].x + v[j].y * v[j].y) + (v[j].z * v[j].z + v[j].w * v[j].w); }
    ss = wave_sum(ss);
    const float rstd = rsqrtf(ss * (1.f / 2048.f) + 1e-6f);
#pragma unroll
    for (int j = 0; j < 8; ++j) { const f32x4 g = *(const f32x4*)(gain + 4 * lane + 256 * j); *(f32x4*)(row + 4 * lane + 256 * j) = (v[j] * rstd) * g; }
}

struct EpiSwiglu {
    static constexpr bool PERM = true, AFTER_DRAIN = false;
    bf16_t* O; int ldc;
    __device__ __forceinline__ void operator()(const f32x4 (&acc)[2][2][4][2], const Unit& u, int wr, int wc, int fr, int fq) const {
        const int row0 = u.pm * 256 + wr * 64 + fr, col0 = u.pn * 128 + wc * 32 + 8 * fq;
#pragma unroll
        for (int ai = 0; ai < 2; ++ai)
#pragma unroll
            for (int m = 0; m < 4; ++m) {
                const f32x4 g0 = acc[ai][0][m][0], g1 = acc[ai][0][m][1], u0 = acc[ai][1][m][0], u1 = acc[ai][1][m][1];
                u32x4 w;
                w.x = pk2(silu_f(g0[0]) * u0[0], silu_f(g0[1]) * u0[1]); w.y = pk2(silu_f(g0[2]) * u0[2], silu_f(g0[3]) * u0[3]);
                w.z = pk2(silu_f(g1[0]) * u1[0], silu_f(g1[1]) * u1[1]); w.w = pk2(silu_f(g1[2]) * u1[2], silu_f(g1[3]) * u1[3]);
                *(u32x4*)(O + (size_t)(row0 + ai * 128 + m * 16) * ldc + col0) = w; }
    }
};
struct EpiResid {
    static constexpr bool PERM = false, AFTER_DRAIN = false;
    const float* inL; const float* inC; float* outL; float* outC; const float* gate0; float s;
    __device__ __forceinline__ void operator()(const f32x4 (&acc)[2][2][4][2], const Unit& u, int wr, int wc, int fr, int fq) const {
        const bool lat = u.pm < 64; const int bm = lat ? (u.pm >> 4) : 4; const int rb = lat ? u.pm * 256 : (u.pm - 64) * 256;
        const float* in = lat ? inL : inC; float* out = lat ? outL : outC; const float* gate = gate0 + (size_t)bm * NMOD;
        const int row0 = rb + wr * 64 + fr, col0 = u.pn * 256 + wc * 32 + 4 * fq;
        f32x4 gv[2][2];
#pragma unroll
        for (int bj = 0; bj < 2; ++bj)
#pragma unroll
            for (int n = 0; n < 2; ++n) gv[bj][n] = *(const f32x4*)(gate + col0 + bj * 128 + n * 16) * s;
#pragma unroll
        for (int ai = 0; ai < 2; ++ai)
#pragma unroll
            for (int m = 0; m < 4; ++m) { const size_t off = (size_t)(row0 + ai * 128 + m * 16) * D + col0;
#pragma unroll
                for (int bj = 0; bj < 2; ++bj)
#pragma unroll
                    for (int n = 0; n < 2; ++n) { const f32x4 x = *(const f32x4*)(in + off + bj * 128 + n * 16); *(f32x4*)(out + off + bj * 128 + n * 16) = x + gv[bj][n] * acc[ai][bj][m][n]; } }
    }
};
struct EpiWin {
    static constexpr bool PERM = true, AFTER_DRAIN = false;
    bf16_t* PH; bf16_t* PQKV; bf16_t* PB; float* ABF;
    __device__ __forceinline__ void operator()(const f32x4 (&acc)[2][2][4][2], const Unit& u, int wr, int wc, int fr, int fq) const {
        const int row0 = u.pm * 256 + wr * 64 + fr, cin = wc * 32 + 8 * fq; const int pn = u.pn;
        if (pn == 28) {
            if (wc == 0) {
#pragma unroll
                for (int ai = 0; ai < 2; ++ai)
#pragma unroll
                    for (int m = 0; m < 4; ++m) { float* p = ABF + (size_t)(row0 + ai * 128 + m * 16) * 32 + 8 * fq; *(f32x4*)p = acc[ai][0][m][0]; *(f32x4*)(p + 4) = acc[ai][0][m][1]; } }
            return; }
        if (pn < 12) {
#pragma unroll
            for (int ai = 0; ai < 2; ++ai)
#pragma unroll
                for (int m = 0; m < 4; ++m) { const int r = row0 + ai * 128 + m * 16; const size_t bt = (size_t)(r >> 12) * 4096 + (r & 4095);
#pragma unroll
                    for (int bj = 0; bj < 2; ++bj) { const f32x4 v0 = acc[ai][bj][m][0], v1 = acc[ai][bj][m][1];
                        const unsigned p0 = pk2(v0[0], v0[1]), p1 = pk2(v0[2], v0[3]), p2 = pk2(v1[0], v1[1]), p3 = pk2(v1[2], v1[3]);
                        bf16_t* cp = PH + (size_t)(256 * pn + bj * 128 + cin) * 16384 + bt;
                        cp[0 * 16384] = (bf16_t)(p0 & 0xffffu); cp[1 * 16384] = (bf16_t)(p0 >> 16); cp[2 * 16384] = (bf16_t)(p1 & 0xffffu); cp[3 * 16384] = (bf16_t)(p1 >> 16);
                        cp[4 * 16384] = (bf16_t)(p2 & 0xffffu); cp[5 * 16384] = (bf16_t)(p2 >> 16); cp[6 * 16384] = (bf16_t)(p3 & 0xffffu); cp[7 * 16384] = (bf16_t)(p3 >> 16); } }
            return; }
        bf16_t* base; int ldc; bool sg = false;
        if (pn < 24) { base = PQKV + 256 * (pn - 12); ldc = 3072; }
        else if (pn < 28) { base = PB + 256 * (pn - 24); ldc = 5120; }
        else { base = PB + 1024 + 256 * (pn - 29); ldc = 5120; sg = true; }
#pragma unroll
        for (int ai = 0; ai < 2; ++ai)
#pragma unroll
            for (int m = 0; m < 4; ++m) { bf16_t* rowp = base + (size_t)(row0 + ai * 128 + m * 16) * ldc + cin;
#pragma unroll
                for (int bj = 0; bj < 2; ++bj) { f32x4 v0 = acc[ai][bj][m][0], v1 = acc[ai][bj][m][1];
                    if (sg) {
#pragma unroll
                        for (int j = 0; j < 4; ++j) { v0[j] = sigm_f(v0[j]); v1[j] = sigm_f(v1[j]); } }
                    u32x4 w; w.x = pk2(v0[0], v0[1]); w.y = pk2(v0[2], v0[3]); w.z = pk2(v1[0], v1[1]); w.w = pk2(v1[2], v1[3]);
                    *(u32x4*)(rowp + bj * 128) = w; } }
    }
};
template <int SECOND> struct EpiMerge {
    static constexpr bool PERM = false, AFTER_DRAIN = false;
    const bf16_t* gates; float* TMP; bf16_t* OUT;
    __device__ __forceinline__ void operator()(const f32x4 (&acc)[2][2][4][2], const Unit& u, int wr, int wc, int fr, int fq) const {
        const int row0 = u.pm * 256 + wr * 64 + fr, col0 = u.pn * 256 + wc * 32 + 4 * fq;
#pragma unroll
        for (int ai = 0; ai < 2; ++ai)
#pragma unroll
            for (int m = 0; m < 4; ++m) { const size_t r = (size_t)(row0 + ai * 128 + m * 16);
#pragma unroll
                for (int bj = 0; bj < 2; ++bj)
#pragma unroll
                    for (int n = 0; n < 2; ++n) { const int c = col0 + bj * 128 + n * 16;
                        const u32x2 gw = *(const u32x2*)(gates + r * 5120 + c);
                        const f32x4 g = (f32x4){bflo(gw.x), bfhi(gw.x), bflo(gw.y), bfhi(gw.y)};
                        if (SECOND == 0) { const f32x4 t = g * acc[ai][bj][m][n]; u32x2 w; w.x = pk2(t.x, t.y); w.y = pk2(t.z, t.w); *(u32x2*)((bf16_t*)TMP + r * D + c) = w; }
                        else { const u32x2 pw = *(const u32x2*)((const bf16_t*)TMP + r * D + c);
                            const f32x4 t = (f32x4){bflo(pw.x), bfhi(pw.x), bflo(pw.y), bfhi(pw.y)} + g * acc[ai][bj][m][n]; u32x2 w; w.x = pk2(t.x, t.y); w.y = pk2(t.z, t.w); *(u32x2*)(OUT + r * D + c) = w; } } }
    }
};
struct CtxSplitOrder {
    int G, c;
    __device__ bool next(int i, Unit& u) const { const long L = (long)i * G + c; if (L >= 128) return false;
        u.kq = (int)(L & 3); u.pn = (int)((L >> 2) & 7); u.pm = (int)(L >> 5); return true; }
    __device__ __forceinline__ void a_ready(const Unit&) const {}
    __device__ __forceinline__ void done(const Unit&) const {}
};
struct EpiCtxPart {
    static constexpr bool PERM = false, AFTER_DRAIN = false;
    float* P; const float* gate; float s;
    __device__ __forceinline__ void operator()(const f32x4 (&acc)[2][2][4][2], const Unit& u, int wr, int wc, int fr, int fq) const {
        const int row0 = u.pm * 256 + wr * 64 + fr, col0 = u.pn * 256 + wc * 32 + 4 * fq; float* out = P + (size_t)u.kq * MC * D;
        f32x4 gv[2][2];
#pragma unroll
        for (int bj = 0; bj < 2; ++bj)
#pragma unroll
            for (int n = 0; n < 2; ++n) gv[bj][n] = *(const f32x4*)(gate + col0 + bj * 128 + n * 16) * s;
#pragma unroll
        for (int ai = 0; ai < 2; ++ai)
#pragma unroll
            for (int m = 0; m < 4; ++m) { const size_t off = (size_t)(row0 + ai * 128 + m * 16) * D + col0;
#pragma unroll
                for (int bj = 0; bj < 2; ++bj)
#pragma unroll
                    for (int n = 0; n < 2; ++n) *(f32x4*)(out + off + bj * 128 + n * 16) = gv[bj][n] * acc[ai][bj][m][n]; }
    }
};
struct WinOrder : pg8::StaticOrder {
    __device__ bool next(int i, Unit& u) const {
        if (pg8::StaticOrder::next(i, u)) return true;
        const long L = (long)i * G + c - nwg; if (L >= 52) return false;
        const int q = (int)(L % 13); u.pm = 64 + (int)(L / 13); u.pn = q < 12 ? 12 + q : 28; u.kq = 0; return true;
    }
};

__device__ __forceinline__ void phase_mod(const float* c, const float* c_ctx, const float* w_mod, const float* b_mod, float* MOD, unsigned char* smem, int tid) {
    float* sS = (float*)smem;
    float* sR = (float*)(smem + 40960);
    const int lane = tid & 63, wv = tid >> 6;
    for (int wg = blockIdx.x; wg < 144; wg += gridDim.x) {
        const int col0 = wg * 128;
        for (int idx = tid; idx < 5 * 2048; idx += 512) { const int r = idx >> 11, k = idx & 2047; const float cv = r < 4 ? c[r * 2048 + k] : c_ctx[k]; sS[idx] = cv / (1.f + expf(-cv)); }
        __syncthreads();
        float a0[5], a1[5];
#pragma unroll
        for (int r = 0; r < 5; ++r) { a0[r] = 0.f; a1[r] = 0.f; }
        const int kb = wv * 256;
#pragma unroll 8
        for (int k = kb; k < kb + 256; ++k) {
            const f32x2 w = *(const f32x2*)(w_mod + (size_t)k * NMOD + col0 + 2 * lane);
#pragma unroll
            for (int r = 0; r < 5; ++r) { const float s = sS[r * 2048 + k]; a0[r] += s * w.x; a1[r] += s * w.y; } }
#pragma unroll
        for (int r = 0; r < 5; ++r) { sR[(wv * 5 + r) * 128 + 2 * lane] = a0[r]; sR[(wv * 5 + r) * 128 + 2 * lane + 1] = a1[r]; }
        __syncthreads();
        for (int idx = tid; idx < 5 * 128; idx += 512) { const int r = idx >> 7, cc = idx & 127; float s = 0.f;
#pragma unroll
            for (int w = 0; w < 8; ++w) s += sR[(w * 5 + r) * 128 + cc];
            MOD[(size_t)r * NMOD + col0 + cc] = s + b_mod[col0 + cc]; }
        __syncthreads();
    }
}
__device__ __forceinline__ void phase_h2(const float* w1, const float* b1, const float* w2, const float* b2, const float* freq, float* H2, int gw, int ngw, int lane) {
    for (int t = gw; t < 4096; t += ngw) {
        const float tt = (float)t * (1.f / 4096.f);
        float zf = 0.f;
        if (lane == 0) zf = tt;
        else if (lane <= 16) { const float f = 1e-4f + (float)(lane - 1) * ((15.f - 1e-4f) / 15.f); zf = cosf((6.283185307179586f * tt) * f); }
        else if (lane <= 32) { const float f = 1e-4f + (float)(lane - 17) * ((15.f - 1e-4f) / 15.f); zf = -sinf((6.283185307179586f * tt) * f); }
        float a = 0.f;
        for (int e = 0; e < 33; ++e) a += __shfl(zf, e) * w1[e * 64 + lane];
        const float fr = freq[lane];
        const float h1 = sinf(fr * (a + b1[lane]));
        float a2 = 0.f;
        for (int j = 0; j < 64; ++j) a2 += __shfl(h1, j) * w2[j * 64 + lane];
        H2[t * 64 + lane] = sinf(fr * (a2 + b2[lane]));
    }
}

__device__ __forceinline__ void gdn_conv_rows(bf16_t* PQKV, const unsigned short* sRaw, int r0, int T, int hc, int cc, float w00, float w01, float w10, float w11, float w20, float w21, int lane, int wv) {
    for (int i = wv; i < T; i += 8) {
        const unsigned x0 = *(const unsigned*)(sRaw + i * 128 + 2 * lane);
        const unsigned xm = i > 0 ? *(const unsigned*)(sRaw + (i - 1) * 128 + 2 * lane) : 0u;
        const unsigned xp = i < T - 1 ? *(const unsigned*)(sRaw + (i + 1) * 128 + 2 * lane) : 0u;
        float y0 = w00 * bflo(xm) + w10 * bflo(x0) + w20 * bflo(xp);
        float y1 = w01 * bfhi(xm) + w11 * bfhi(x0) + w21 * bfhi(xp);
        y0 = silu_f(y0); y1 = silu_f(y1);
        if (hc < 16) { const float ss = wave_sum(y0 * y0 + y1 * y1); float sc = rsqrtf(ss + 1e-6f); if (hc < 8) sc *= 0.08838834764831845f; y0 *= sc; y1 *= sc; }
        *(unsigned*)(PQKV + (size_t)(r0 + i) * 3072 + cc) = pk2(y0, y1);
    }
}
__device__ __forceinline__ void phase_gdn_conv(bf16_t* PQKV, const float* conv_w, unsigned char* smem, int tid) {
    unsigned short* sRaw = (unsigned short*)smem;
    const int lane = tid & 63, wv = tid >> 6;
    {
        const int rowa = tid >> 4, part = tid & 15;
        u32x4 xa = (u32x4){0u, 0u, 0u, 0u}, xb = xa; float n00 = 0.f, n01 = 0.f, n10 = 0.f, n11 = 0.f, n20 = 0.f, n21 = 0.f;
#define GC_LOAD(it_) do { const int seg_ = (it_) / 24, hc_ = (it_) % 24; const bf16_t* p_ = PQKV + (size_t)(seg_ * 64 + rowa) * 3072 + hc_ * 128 + part * 8; \
            xa = *(const u32x4*)p_; xb = *(const u32x4*)(p_ + (size_t)32 * 3072); const int cc_ = hc_ * 128 + 2 * lane; \
            n00 = conv_w[cc_]; n01 = conv_w[cc_ + 1]; n10 = conv_w[3072 + cc_]; n11 = conv_w[3072 + cc_ + 1]; n20 = conv_w[6144 + cc_]; n21 = conv_w[6144 + cc_ + 1]; } while (0)
        int item = blockIdx.x;
        if (item < 6144) GC_LOAD(item);
        for (; item < 6144; item += gridDim.x) {
            const int seg = item / 24, hc = item % 24;
            const u32x4 ca = xa, cb = xb; const float w00 = n00, w01 = n01, w10 = n10, w11 = n11, w20 = n20, w21 = n21;
            *(u32x4*)(sRaw + rowa * 128 + part * 8) = ca; *(u32x4*)(sRaw + (rowa + 32) * 128 + part * 8) = cb;
            __syncthreads();
            if (item + (int)gridDim.x < 6144) GC_LOAD(item + (int)gridDim.x);
            gdn_conv_rows(PQKV, sRaw, seg * 64, 64, hc, hc * 128 + 2 * lane, w00, w01, w10, w11, w20, w21, lane, wv);
            __syncthreads();
        }
#undef GC_LOAD
    }
    for (int item = 6144 + blockIdx.x; item < 6144 + 64; item += gridDim.x) {
        const int q = item - 6144, hc = 8 + (q & 15), r0 = ML + (q >> 4) * 256, T = 256;
        const int col0 = hc * 128;
        for (int ch = tid; ch < T * 16; ch += 512) { const int row = ch >> 4, part = ch & 15;
            *(u32x4*)(sRaw + row * 128 + part * 8) = *(const u32x4*)(PQKV + (size_t)(r0 + row) * 3072 + col0 + part * 8); }
        const int cc = col0 + 2 * lane;
        const float w00 = conv_w[cc], w01 = conv_w[cc + 1], w10 = conv_w[3072 + cc], w11 = conv_w[3072 + cc + 1], w20 = conv_w[6144 + cc], w21 = conv_w[6144 + cc + 1];
        __syncthreads();
        gdn_conv_rows(PQKV, sRaw, r0, T, hc, cc, w00, w01, w10, w11, w20, w21, lane, wv);
        __syncthreads();
    }
}
__device__ __forceinline__ void phase_gbeta(const float* ABF, const float* a_log, const float* dt_bias, float* G, float* BETA, int gtid, int ngt) {
    for (int idx = gtid; idx < MT * 16; idx += ngt) { const int r = idx >> 4, e = idx & 15;
        const float a = ABF[(size_t)r * 32 + e] + dt_bias[e], bb = ABF[(size_t)r * 32 + 16 + e];
        const float sp = a > 20.f ? a : log1pf(expf(a));
        G[idx] = -expf(a_log[e]) * sp; BETA[idx] = 1.f / (1.f + expf(-bb)); }
}

__device__ __forceinline__ int chunk_row(int item, int i, int& h, int& dir) {
    int n, b, Ls, rb;
    if (item < 4096) { n = item & 63; h = (item >> 6) & 7; b = (item >> 9) & 3; dir = item >> 11; Ls = SEQ; rb = b * SEQ; }
    else { const int q = item - 4096; n = q & 3; h = (q >> 2) & 7; b = (q >> 5) & 3; dir = q >> 7; Ls = CTXL; rb = ML + b * CTXL; }
    const int p = n * 64 + i;
    return rb + (dir ? Ls - 1 - p : p);
}
__device__ __forceinline__ unsigned pk2_rne(float lo, float hi) { return pk2(lo, hi); }
#define PREP_MFMA(a_, b_, c_) __builtin_amdgcn_mfma_f32_16x16x32_bf16(__builtin_bit_cast(pg8::bf16x8, (a_)), __builtin_bit_cast(pg8::bf16x8, (b_)), (c_), 0, 0, 0)
__device__ __forceinline__ void phase_gdn_prep(const bf16_t* PQKV, const float* G, const float* BETA, bf16_t* U, bf16_t* W, bf16_t* QK, float* GC, unsigned char* smem, int tid) {
    const int lane = tid & 63, wv = tid >> 6, fr = lane & 15, fq = lane >> 4;
    float* sT = (float*)(smem + wv * 18176);
    float* sGc = sT + 64 * 68;
    float* sBe = sGc + 64;
    float* sBg = sBe + 64;
    for (int item = blockIdx.x * 8 + wv; item < NITEM; item += gridDim.x * 8) {
        int n, h, b, dir, Ls, rb;
        if (item < 4096) { n = item & 63; h = (item >> 6) & 7; b = (item >> 9) & 3; dir = item >> 11; Ls = SEQ; rb = b * SEQ; }
        else { const int q = item - 4096; n = q & 3; h = (q >> 2) & 7; b = (q >> 5) & 3; dir = q >> 7; Ls = CTXL; rb = ML + b * CTXL; }
        const int r0 = rb + (dir ? Ls - 1 - n * 64 : n * 64), sg = dir ? -1 : 1;
        {
            const int row = r0 + sg * lane;
            float g = G[(size_t)row * 16 + dir * 8 + h]; const float be = BETA[(size_t)row * 16 + dir * 8 + h];
#pragma unroll
            for (int o = 1; o < 64; o <<= 1) { const float t = __shfl_up(g, o); if (lane >= o) g += t; }
            sGc[lane] = g; sBe[lane] = be; sBg[lane] = be * expf(g);
            const float gl = __shfl(g, 63);
            GC[(size_t)item * 128 + lane] = expf(g); GC[(size_t)item * 128 + 64 + lane] = expf(gl - g);
        }
        LDS_WAIT();
        const bf16_t* base = PQKV + h * 128 + fq * 8;
        {
            u32x4 kf[4][4];
#pragma unroll
            for (int t4 = 0; t4 < 4; ++t4) { const bf16_t* ip = base + (size_t)(r0 + sg * (t4 * 16 + fr)) * 3072;
#pragma unroll
                for (int kc = 0; kc < 4; ++kc) kf[t4][kc] = *(const u32x4*)(ip + 1024 + kc * 32); }
#pragma unroll
            for (int ti = 0; ti < 4; ++ti) {
                const int i = ti * 16 + fr; const float gi = sGc[i], bi = sBe[i];
                u32x4 qx[4];
                { const bf16_t* ip = base + (size_t)(r0 + sg * i) * 3072;
#pragma unroll
                  for (int kc = 0; kc < 4; ++kc) qx[kc] = *(const u32x4*)(ip + kc * 32); }
#pragma unroll
                for (int tj = 0; tj < 4; ++tj) {
                    f32x4 aa = (f32x4){0.f, 0.f, 0.f, 0.f}, aq = (f32x4){0.f, 0.f, 0.f, 0.f};
                    if (tj <= ti) {
#pragma unroll
                        for (int kc = 0; kc < 4; ++kc) { aa = PREP_MFMA(kf[tj][kc], kf[ti][kc], aa); aq = PREP_MFMA(kf[tj][kc], qx[kc], aq); }
                    }
                    const int j0 = tj * 16 + fq * 4; const f32x4 gj = *(const f32x4*)(sGc + j0);
                    float av[4], qv[4];
#pragma unroll
                    for (int jj = 0; jj < 4; ++jj) { const int j = j0 + jj; const float dec = i >= j ? __expf(gi - gj[jj]) : 0.f;
                        av[jj] = i > j ? bi * aa[jj] * dec : 0.f; qv[jj] = aq[jj] * dec; }
                    if (tj <= ti) *(f32x4*)(sT + i * 68 + j0) = (f32x4){av[0], av[1], av[2], av[3]};
                    u32x2 p; p.x = pk2_rne(qv[0], qv[1]); p.y = pk2_rne(qv[2], qv[3]);
                    *(u32x2*)(QK + ((size_t)item * 64 + i) * 64 + j0) = p;
                }
            }
        }
        LDS_WAIT();
        {
            float t[64]; const float lanef = (float)lane;
#pragma unroll
            for (int i = 0; i < 64; ++i) {
                float a = fmaxf(0.f, 1.f - fabsf(lanef - (float)i));
#pragma unroll
                for (int j0 = 0; j0 < i; j0 += 4) { const f32x4 ar = *(const f32x4*)(sT + i * 68 + j0);
                    a -= ar.x * t[j0];
                    if (j0 + 1 < i) a -= ar.y * t[j0 + 1];
                    if (j0 + 2 < i) a -= ar.z * t[j0 + 2];
                    if (j0 + 3 < i) a -= ar.w * t[j0 + 3]; }
                t[i] = a;
            }
            LDS_WAIT();
#pragma unroll
            for (int i = 0; i < 64; ++i) sT[i * 68 + lane] = t[i];
        }
        LDS_WAIT();
#define PREP_X(X_, SC_) do { \
            _Pragma("unroll") for (int ti_ = 0; ti_ < 4; ++ti_) _Pragma("unroll") for (int kc_ = 0; kc_ < 2; ++kc_) { \
                if (kc_ * 32 > ti_ * 16 + 15) { X_[ti_][kc_] = (u32x4){0u, 0u, 0u, 0u}; continue; } \
                const int jb_ = kc_ * 32 + fq * 8; const float* tp_ = sT + (ti_ * 16 + fr) * 68 + jb_; \
                const f32x4 t0_ = *(const f32x4*)tp_, t1_ = *(const f32x4*)(tp_ + 4); \
                const f32x4 s0_ = *(const f32x4*)((SC_) + jb_), s1_ = *(const f32x4*)((SC_) + jb_ + 4); \
                const f32x4 u0_ = t0_ * s0_, u1_ = t1_ * s1_; \
                X_[ti_][kc_] = (u32x4){pk2(u0_.x, u0_.y), pk2(u0_.z, u0_.w), pk2(u1_.x, u1_.y), pk2(u1_.z, u1_.w)}; } } while (0)
        const bf16_t* vcol = PQKV + h * 128 + fr;
#define PREP_UW(COFF_, X_, DST_) do { u32x4 y_[4][2]; \
            _Pragma("unroll") for (int tl_ = 0; tl_ < 4; ++tl_) _Pragma("unroll") for (int kc_ = 0; kc_ < 2; ++kc_) { unsigned e_[8]; \
                _Pragma("unroll") for (int q_ = 0; q_ < 8; ++q_) e_[q_] = vcol[(size_t)(r0 + sg * (kc_ * 32 + fq * 8 + q_)) * 3072 + (COFF_) + (td0 + tl_) * 16]; \
                y_[tl_][kc_] = (u32x4){e_[0] | (e_[1] << 16), e_[2] | (e_[3] << 16), e_[4] | (e_[5] << 16), e_[6] | (e_[7] << 16)}; } \
            _Pragma("unroll") for (int tl_ = 0; tl_ < 4; ++tl_) _Pragma("unroll") for (int ti_ = 0; ti_ < 4; ++ti_) { \
                f32x4 a_ = (f32x4){0.f, 0.f, 0.f, 0.f}; a_ = PREP_MFMA(y_[tl_][0], X_[ti_][0], a_); if (ti_ >= 2) a_ = PREP_MFMA(y_[tl_][1], X_[ti_][1], a_); \
                u32x2 p_; p_.x = pk2_rne(a_[0], a_[1]); p_.y = pk2_rne(a_[2], a_[3]); \
                *(u32x2*)((DST_) + ((size_t)item * 64 + ti_ * 16 + fr) * 128 + (td0 + tl_) * 16 + fq * 4) = p_; } \
            asm volatile("" ::: "memory"); } while (0)
        {   u32x4 xx[4][2];
            PREP_X(xx, sBe);
#pragma unroll 1
            for (int td0 = 0; td0 < 8; td0 += 4) PREP_UW(2048, xx, U);
            PREP_X(xx, sBg);
#pragma unroll 1
            for (int td0 = 0; td0 < 8; td0 += 4) PREP_UW(1024, xx, W);
        }
#undef PREP_UW
#undef PREP_X
        LDS_WAIT();
    }
}

__device__ __forceinline__ unsigned f2bf_bits(float f) { return pk2(f, 0.f) & 0xffffu; }
__device__ __forceinline__ unsigned pk2s(float lo, float hi) { return pk2(lo, hi); }
#define MK_MFMA(a_, b_, c_) __builtin_amdgcn_mfma_f32_16x16x32_bf16(__builtin_bit_cast(pg8::bf16x8, (a_)), __builtin_bit_cast(pg8::bf16x8, (b_)), (c_), 0, 0, 0)
__device__ __forceinline__ void phase_scan(const bf16_t* PQKV, const bf16_t* U, const bf16_t* W, const bf16_t* QK, const float* GC, bf16_t* O, unsigned char* smem, int tid, int vb) {
    unsigned short* sSt = (unsigned short*)smem;
    unsigned short* sVt = sSt + 32 * 136;
    unsigned short* sVd = sVt + 32 * 72;
    unsigned short* sKt = sVd + 32 * 72;
    float* sE = (float*)(sKt + 2 * 128 * 72);
    const int lane = tid & 63, w = tid >> 6, fr = lane & 15, fq = lane >> 4, ti = w >> 1, te = w & 1;
    for (int wg = vb; wg < 256; wg += gridDim.x) {
        const int dir = wg >> 7, b = (wg >> 5) & 3, h = (wg >> 2) & 7, sl = wg & 3;
        const int dbh = (dir * 4 + b) * 8 + h;
        __syncthreads();
        for (int idx = tid; idx < 32 * 136; idx += 512) sSt[idx] = 0;
        f32x4 S0 = (f32x4){0.f, 0.f, 0.f, 0.f}, S1 = (f32x4){0.f, 0.f, 0.f, 0.f};
        u32x4 wf[4], qf[4], qkf[2], kr[2]; unsigned short ur[4]; float gcr = 0.f;
#pragma unroll
        for (int k = 0; k < 4; ++k) qf[k] = (u32x4){0u, 0u, 0u, 0u};
        qkf[0] = qkf[1] = (u32x4){0u, 0u, 0u, 0u};
#define SCAN_LOAD(step_) do { const int st_ = (step_); const bool lat_ = st_ >= 4; const int item_ = lat_ ? dbh * 64 + (st_ - 4) : 4096 + dbh * 4 + st_; \
            const int n_ = lat_ ? st_ - 4 : st_; const int Ls_ = lat_ ? SEQ : CTXL; const int rb_ = lat_ ? b * SEQ : ML + b * CTXL; \
            { const bf16_t* wp_ = W + (size_t)item_ * 8192 + (ti * 16 + fr) * 128 + fq * 8; \
              _Pragma("unroll") for (int kc_ = 0; kc_ < 4; ++kc_) wf[kc_] = *(const u32x4*)(wp_ + kc_ * 32); } \
            if (lat_) { const int p_ = n_ * 64 + ti * 16 + fr; const int row_ = rb_ + (dir ? Ls_ - 1 - p_ : p_); \
              const bf16_t* qp_ = PQKV + (size_t)row_ * 3072 + h * 128 + fq * 8; \
              _Pragma("unroll") for (int kc_ = 0; kc_ < 4; ++kc_) qf[kc_] = *(const u32x4*)(qp_ + kc_ * 32); \
              const bf16_t* qkp_ = QK + (size_t)item_ * 4096 + (ti * 16 + fr) * 64 + fq * 8; qkf[0] = *(const u32x4*)qkp_; qkf[1] = *(const u32x4*)(qkp_ + 32); } \
            { const int p_ = n_ * 64 + lane; const int row_ = rb_ + (dir ? Ls_ - 1 - p_ : p_); \
              const bf16_t* kp_ = PQKV + (size_t)row_ * 3072 + 1024 + h * 128 + w * 16; kr[0] = *(const u32x4*)kp_; kr[1] = *(const u32x4*)(kp_ + 8); } \
            _Pragma("unroll") for (int j_ = 0; j_ < 4; ++j_) ur[j_] = U[((size_t)item_ * 64 + ti * 16 + fq * 4 + j_) * 128 + sl * 32 + te * 16 + fr]; \
            if (tid < 128) gcr = GC[(size_t)item_ * 128 + tid]; } while (0)
#define SCAN_STAGE(buf_) do { unsigned short* kb_ = sKt + (buf_) * (128 * 72); \
            _Pragma("unroll") for (int hh_ = 0; hh_ < 2; ++hh_) { const u32x4 k_ = kr[hh_]; unsigned short* d_ = kb_ + (w * 16 + hh_ * 8) * 72 + lane; \
                d_[0 * 72] = (unsigned short)(k_.x & 0xffffu); d_[1 * 72] = (unsigned short)(k_.x >> 16); d_[2 * 72] = (unsigned short)(k_.y & 0xffffu); d_[3 * 72] = (unsigned short)(k_.y >> 16); \
                d_[4 * 72] = (unsigned short)(k_.z & 0xffffu); d_[5 * 72] = (unsigned short)(k_.z >> 16); d_[6 * 72] = (unsigned short)(k_.w & 0xffffu); d_[7 * 72] = (unsigned short)(k_.w >> 16); } \
            if (tid < 128) sE[(buf_) * 128 + tid] = gcr; } while (0)
        SCAN_LOAD(0);
        SCAN_STAGE(0);
        u32x4 cw[4], cq[4], cqk[2]; float cu[4];
#pragma unroll
        for (int k = 0; k < 4; ++k) { cw[k] = wf[k]; cq[k] = qf[k]; cu[k] = bf2f(ur[k]); }
        cqk[0] = qkf[0]; cqk[1] = qkf[1];
        int pb = 0;
        for (int step = 0; step < 68; ++step) {
            const bool lat = step >= 4;
            if (step + 1 < 68) SCAN_LOAD(step + 1);
            __syncthreads();
            const float* sEg = sE + pb * 128; const float* sEd = sEg + 64; const unsigned short* sKc = sKt + pb * (128 * 72);
            f32x4 aW = (f32x4){0.f, 0.f, 0.f, 0.f}, aQ = (f32x4){0.f, 0.f, 0.f, 0.f};
#pragma unroll
            for (int kc = 0; kc < 4; ++kc) { const u32x4 y = *(const u32x4*)(sSt + (te * 16 + fr) * 136 + kc * 32 + fq * 8);
                aW = MK_MFMA(cw[kc], y, aW); if (lat) aQ = MK_MFMA(cq[kc], y, aQ); }
            const int i0 = ti * 16 + fq * 4;
            { float vn[4], vd[4];
#pragma unroll
              for (int j = 0; j < 4; ++j) { vn[j] = cu[j] - aW[j]; vd[j] = vn[j] * sEd[i0 + j]; }
              u32x2 p; p.x = pk2s(vn[0], vn[1]); p.y = pk2s(vn[2], vn[3]); *(u32x2*)(sVt + (te * 16 + fr) * 72 + i0) = p;
              p.x = pk2s(vd[0], vd[1]); p.y = pk2s(vd[2], vd[3]); *(u32x2*)(sVd + (te * 16 + fr) * 72 + i0) = p; }
            __syncthreads();
            if (lat) {
                f32x4 ao;
#pragma unroll
                for (int j = 0; j < 4; ++j) ao[j] = aQ[j] * sEg[i0 + j];
#pragma unroll
                for (int kc = 0; kc < 2; ++kc) { const u32x4 y = *(const u32x4*)(sVt + (te * 16 + fr) * 72 + kc * 32 + fq * 8); ao = MK_MFMA(cqk[kc], y, ao); }
                const int n = step - 4;
#pragma unroll
                for (int j = 0; j < 4; ++j) { const int p = n * 64 + i0 + j; const int pos = dir ? SEQ - 1 - p : p;
                    O[((size_t)dir * ML + (size_t)b * SEQ + pos) * 1024 + h * 128 + sl * 32 + te * 16 + fr] = (bf16_t)f2bf_bits(ao[j]); }
            }
            {
                const float egl = sEg[63];
                S0 = S0 * egl; S1 = S1 * egl;
#pragma unroll
                for (int kc = 0; kc < 2; ++kc) { const u32x4 x = *(const u32x4*)(sKc + (w * 16 + fr) * 72 + kc * 32 + fq * 8);
                    const u32x4 y0 = *(const u32x4*)(sVd + fr * 72 + kc * 32 + fq * 8), y1 = *(const u32x4*)(sVd + (16 + fr) * 72 + kc * 32 + fq * 8);
                    S0 = MK_MFMA(x, y0, S0); S1 = MK_MFMA(x, y1, S1); }
                u32x2 p; p.x = pk2s(S0[0], S0[1]); p.y = pk2s(S0[2], S0[3]); *(u32x2*)(sSt + fr * 136 + w * 16 + fq * 4) = p;
                p.x = pk2s(S1[0], S1[1]); p.y = pk2s(S1[2], S1[3]); *(u32x2*)(sSt + (16 + fr) * 136 + w * 16 + fq * 4) = p;
            }
            if (step + 1 < 68) {
                SCAN_STAGE(pb ^ 1);
#pragma unroll
                for (int k = 0; k < 4; ++k) { cw[k] = wf[k]; cq[k] = qf[k]; cu[k] = bf2f(ur[k]); }
                cqk[0] = qkf[0]; cqk[1] = qkf[1];
            }
            pb ^= 1;
        }
#undef SCAN_LOAD
#undef SCAN_STAGE
    }
}

__device__ __forceinline__ void phase_ogate(const bf16_t* O, bf16_t* OG, const bf16_t* PB, const float* gn, int gw, int ngw, int lane) {
    for (int r = gw; r < ML; r += ngw) {
        const bf16_t* of = O + (size_t)r * 1024 + lane * 16; const bf16_t* ob = of + (size_t)ML * 1024; bf16_t* og = OG + (size_t)r * 1024 + lane * 16; const bf16_t* zp = PB + (size_t)r * 5120 + lane * 16;
        float o[16], z[16];
#pragma unroll
        for (int hh = 0; hh < 2; ++hh) { const u32x4 a = *(const u32x4*)(of + hh * 8), bq = *(const u32x4*)(ob + hh * 8), zz = *(const u32x4*)(zp + hh * 8);
            o[hh * 8 + 0] = bflo(a.x) + bflo(bq.x); o[hh * 8 + 1] = bfhi(a.x) + bfhi(bq.x); o[hh * 8 + 2] = bflo(a.y) + bflo(bq.y); o[hh * 8 + 3] = bfhi(a.y) + bfhi(bq.y);
            o[hh * 8 + 4] = bflo(a.z) + bflo(bq.z); o[hh * 8 + 5] = bfhi(a.z) + bfhi(bq.z); o[hh * 8 + 6] = bflo(a.w) + bflo(bq.w); o[hh * 8 + 7] = bfhi(a.w) + bfhi(bq.w);
            z[hh * 8 + 0] = bflo(zz.x); z[hh * 8 + 1] = bfhi(zz.x); z[hh * 8 + 2] = bflo(zz.y); z[hh * 8 + 3] = bfhi(zz.y);
            z[hh * 8 + 4] = bflo(zz.z); z[hh * 8 + 5] = bfhi(zz.z); z[hh * 8 + 6] = bflo(zz.w); z[hh * 8 + 7] = bfhi(zz.w); }
        float ss = 0.f;
#pragma unroll
        for (int j = 0; j < 16; ++j) ss += o[j] * o[j];
        ss += __shfl_xor(ss, 1); ss += __shfl_xor(ss, 2); ss += __shfl_xor(ss, 4);
        const float rstd = rsqrtf(ss * (1.f / 128.f) + 1e-6f);
        const float* g = gn + (lane & 7) * 16;
        u32x4 w[2];
#pragma unroll
        for (int hh = 0; hh < 2; ++hh) {
            float r8[8];
#pragma unroll
            for (int j = 0; j < 8; ++j) r8[j] = o[hh * 8 + j] * rstd * g[hh * 8 + j] * silu_f(z[hh * 8 + j]);
            w[hh].x = pk2(r8[0], r8[1]); w[hh].y = pk2(r8[2], r8[3]); w[hh].z = pk2(r8[4], r8[5]); w[hh].w = pk2(r8[6], r8[7]); }
        *(u32x4*)og = w[0]; *(u32x4*)(og + 8) = w[1];
    }
}
__device__ __forceinline__ void phase_hy_tin(const bf16_t* PH, const float* cw, const float* cb, bf16_t* HYT, unsigned char* smem, int tid) {
    float* sT = (float*)smem;
    constexpr int NIT = 4 * 32 * 24;
    const int lrow = tid >> 4, lpart = tid & 15;
    const int cj = tid >> 2, cq = tid & 3;
    u32x4 xn[4]; float wn0 = 0.f, wn1 = 0.f, wn2 = 0.f, bn = 0.f;
#pragma unroll
    for (int k = 0; k < 4; ++k) xn[k] = (u32x4){0u, 0u, 0u, 0u};
#define TIN_LOAD(it_) do { const int cbk_ = (it_) % 24, sp_ = ((it_) / 24) & 31, b_ = (it_) / (24 * 32); \
        const bf16_t* p_ = PH + (size_t)(b_ * SEQ + sp_ * 128 + lrow) * 3072 + cbk_ * 128 + lpart * 8; \
        _Pragma("unroll") for (int k_ = 0; k_ < 4; ++k_) xn[k_] = *(const u32x4*)(p_ + (size_t)(32 * k_) * 3072); \
        const int col_ = cbk_ * 128 + cj; wn0 = cw[col_]; wn1 = cw[3072 + col_]; wn2 = cw[6144 + col_]; bn = cb[col_]; } while (0)
    int item = blockIdx.x;
    if (item < NIT) TIN_LOAD(item);
    for (; item < NIT; item += gridDim.x) {
        const int cbk = item % 24, sp = (item / 24) & 31, b = item / (24 * 32);
        u32x4 x[4];
#pragma unroll
        for (int k = 0; k < 4; ++k) x[k] = xn[k];
        const float w0 = wn0, w1 = wn1, w2 = wn2, bi = bn;
        if (item + (int)gridDim.x < NIT) TIN_LOAD(item + (int)gridDim.x);
#pragma unroll
        for (int k = 0; k < 4; ++k) { float* d = sT + (lrow + 32 * k) * 129 + lpart * 8;
            d[0] = bflo(x[k].x); d[1] = bfhi(x[k].x); d[2] = bflo(x[k].y); d[3] = bfhi(x[k].y); d[4] = bflo(x[k].z); d[5] = bfhi(x[k].z); d[6] = bflo(x[k].w); d[7] = bfhi(x[k].w); }
        __syncthreads();
        { const int col = cbk * 128 + cj;
#pragma unroll
          for (int k = 0; k < 4; ++k) { const int i0 = 8 * (cq + 4 * k); float y[8];
#pragma unroll
              for (int ii = 0; ii < 8; ++ii) { const int i = i0 + ii; const float xm = (i & 63) > 0 ? sT[(i - 1) * 129 + cj] : 0.f, x0 = sT[i * 129 + cj], xp = (i & 63) < 63 ? sT[(i + 1) * 129 + cj] : 0.f;
                  y[ii] = w0 * xm + w1 * x0 + w2 * xp + bi; }
              u32x4 w; w.x = pk2(y[0], y[1]); w.y = pk2(y[2], y[3]); w.z = pk2(y[4], y[5]); w.w = pk2(y[6], y[7]);
              *(u32x4*)(HYT + ((size_t)col * 4 + b) * 4096 + sp * 128 + i0) = w; } }
        __syncthreads();
    }
#undef TIN_LOAD
}
__device__ __forceinline__ int xi(int i) { return i + ((i >> 5) << 1); }
constexpr int XSZ_BYTES = (8192 + 512) * 8;
__device__ __forceinline__ f32x2 cmul(f32x2 a, f32x2 b) { return (f32x2){a.x * b.x - a.y * b.y, a.x * b.y + a.y * b.x}; }
__device__ __forceinline__ f32x2 twid(const f32x2* TW, int k) { f32x2 w = TW[k & 2047]; if (k & 2048) w = (f32x2){w.y, -w.x}; return w; }
__device__ __forceinline__ void tw_init(f32x2* TW, int tid) {
    for (int k = tid; k < 2048; k += 512) { float s, c; sincospif((float)k * (1.f / 4096.f), &s, &c); TW[k] = (f32x2){c, -s}; }
}
template <int M, bool INV> __device__ __forceinline__ f32x2 cmul8(f32x2 d) {
    constexpr float C8[8] = {1.f, 0.9238795325112867f, 0.7071067811865476f, 0.3826834323650898f, 0.f, -0.3826834323650898f, -0.7071067811865476f, -0.9238795325112867f};
    constexpr float S8[8] = {0.f, 0.3826834323650898f, 0.7071067811865476f, 0.9238795325112867f, 1.f, 0.9238795325112867f, 0.7071067811865476f, 0.3826834323650898f};
    constexpr float r = 0.7071067811865476f;
    if constexpr (M == 0) return d;
    else if constexpr (M == 4) return INV ? (f32x2){-d.y, d.x} : (f32x2){d.y, -d.x};
    else if constexpr (M == 2) return INV ? (f32x2){(d.x - d.y) * r, (d.x + d.y) * r} : (f32x2){(d.x + d.y) * r, (d.y - d.x) * r};
    else if constexpr (M == 6) return INV ? (f32x2){-(d.x + d.y) * r, (d.x - d.y) * r} : (f32x2){(d.y - d.x) * r, -(d.x + d.y) * r};
    else return cmul(d, (f32x2){C8[M], INV ? S8[M] : -S8[M]});
}
__device__ __forceinline__ f32x2 twid8(const f32x2* TW, int k) { f32x2 w = twid(TW, k & 4095); if (k & 4096) w = (f32x2){-w.x, -w.y}; return w; }
template <int K, bool INV> __device__ __forceinline__ void fft16_stage(f32x2 (&x)[16], const f32x2 tg) {
#define FFT16_BF(E_) do { if constexpr (((E_) & (1 << K)) == 0) { constexpr int m_ = ((E_) & ((1 << K) - 1)) << (3 - K); \
        if constexpr (!INV) { const f32x2 a_ = x[E_], b_ = x[(E_) | (1 << K)]; x[E_] = a_ + b_; x[(E_) | (1 << K)] = cmul(cmul8<m_, false>(a_ - b_), tg); } \
        else { const f32x2 a_ = x[E_], b_ = cmul8<m_, true>(cmul(x[(E_) | (1 << K)], tg)); x[E_] = a_ + b_; x[(E_) | (1 << K)] = a_ - b_; } } } while (0)
    FFT16_BF(0); FFT16_BF(1); FFT16_BF(2); FFT16_BF(3); FFT16_BF(4); FFT16_BF(5); FFT16_BF(6); FFT16_BF(7);
    FFT16_BF(8); FFT16_BF(9); FFT16_BF(10); FFT16_BF(11); FFT16_BF(12); FFT16_BF(13); FFT16_BF(14); FFT16_BF(15);
#undef FFT16_BF
}
template <int P> __device__ __forceinline__ void fft16_fwd(f32x2* X, const f32x2* TW, int tid) {
    const int lo = tid & ((1 << P) - 1), base = ((tid >> P) << (P + 4)) | lo;
    f32x2 x[16];
#pragma unroll
    for (int e = 0; e < 16; ++e) x[e] = X[xi(base | (e << P))];
    const f32x2 t3 = twid(TW, lo << (9 - P)), t2 = cmul(t3, t3), t1 = cmul(t2, t2), t0 = cmul(t1, t1);
    fft16_stage<3, false>(x, t3); fft16_stage<2, false>(x, t2); fft16_stage<1, false>(x, t1); fft16_stage<0, false>(x, t0);
#pragma unroll
    for (int e = 0; e < 16; ++e) X[xi(base | (e << P))] = x[e];
}
template <int P> __device__ __forceinline__ void fft16_inv(f32x2* X, const f32x2* TW, int tid) {
    const int lo = tid & ((1 << P) - 1), base = ((tid >> P) << (P + 4)) | lo;
    f32x2 x[16];
#pragma unroll
    for (int e = 0; e < 16; ++e) x[e] = X[xi(base | (e << P))];
    const f32x2 t3 = twid(TW, lo << (9 - P)), t2 = cmul(t3, t3), t1 = cmul(t2, t2), t0 = cmul(t1, t1);
    fft16_stage<0, true>(x, (f32x2){t0.x, -t0.y}); fft16_stage<1, true>(x, (f32x2){t1.x, -t1.y}); fft16_stage<2, true>(x, (f32x2){t2.x, -t2.y}); fft16_stage<3, true>(x, (f32x2){t3.x, -t3.y});
#pragma unroll
    for (int e = 0; e < 16; ++e) X[xi(base | (e << P))] = x[e];
}
__device__ __forceinline__ void fft_fwd3(f32x2* X, const f32x2* TW, int tid) {
    fft16_fwd<9>(X, TW, tid); __syncthreads(); fft16_fwd<5>(X, TW, tid); __syncthreads(); fft16_fwd<1>(X, TW, tid); __syncthreads();
}
__device__ __forceinline__ void fft_inv3(f32x2* X, const f32x2* TW, int tid) {
    fft16_inv<1>(X, TW, tid); __syncthreads(); fft16_inv<5>(X, TW, tid); __syncthreads(); fft16_inv<9>(X, TW, tid); __syncthreads();
}
__device__ __forceinline__ void fft_mid(f32x2* X, const f32x4 (&kk)[8], int tid) {
#pragma unroll
    for (int u = 0; u < 8; ++u) { const int i = 2 * (tid + 512 * u);
        const f32x4 v = *(const f32x4*)(X + xi(i));
        const f32x2 a = cmul((f32x2){v.x + v.z, v.y + v.w}, (f32x2){kk[u].x, kk[u].y}), b = cmul((f32x2){v.x - v.z, v.y - v.w}, (f32x2){kk[u].z, kk[u].w});
        *(f32x4*)(X + xi(i)) = (f32x4){a.x + b.x, a.y + b.y, a.x - b.x, a.y - b.y}; }
    __syncthreads();
}
#define FFT_KLOAD(kk_, kf_) do { _Pragma("unroll") for (int u_ = 0; u_ < 8; ++u_) kk_[u_] = *(const f32x4*)((kf_) + 2 * (tid + 512 * u_)); } while (0)
__device__ __forceinline__ void split8(const f32x4 a, const f32x4 b, u32x4& hi, u32x4& lo) {
    hi.x = pk2(a.x, a.y); hi.y = pk2(a.z, a.w); hi.z = pk2(b.x, b.y); hi.w = pk2(b.z, b.w);
    lo.x = pk2(a.x - bflo(hi.x), a.y - bfhi(hi.x)); lo.y = pk2(a.z - bflo(hi.y), a.w - bfhi(hi.y));
    lo.z = pk2(b.x - bflo(hi.z), b.y - bfhi(hi.z)); lo.w = pk2(b.z - bflo(hi.w), b.w - bfhi(hi.w));
}
__device__ __forceinline__ void phase_hy_filt(const float* H2, const float* w3, f32x2* KFS, unsigned char* smem, int tid) {
    f32x2* X = (f32x2*)smem; f32x2* TW = (f32x2*)(smem + XSZ_BYTES); float* sRed = (float*)(smem + XSZ_BYTES + 16384);
    const int lane = tid & 63, wv = tid >> 6, fr = lane & 15, fq = lane >> 4;
    tw_init(TW, tid);
    float* KF = (float*)KFS;
    for (int cg = blockIdx.x; cg < 256; cg += gridDim.x) {
        const int c0 = cg * 4;
        const int ch = fr >> 2, ord = (fr >> 1) & 1, dr = fr & 1, c = c0 + ch;
        const int wcol = ord * 2048 + dr * 1024 + c;
        u32x4 yh[2], yl[2];
#pragma unroll
        for (int kc = 0; kc < 2; ++kc) { float wv8[8];
#pragma unroll
            for (int e = 0; e < 8; ++e) wv8[e] = w3[(size_t)(kc * 32 + fq * 8 + e) * 4096 + wcol];
            split8((f32x4){wv8[0], wv8[1], wv8[2], wv8[3]}, (f32x4){wv8[4], wv8[5], wv8[6], wv8[7]}, yh[kc], yl[kc]); }
        const float a0 = -3.0701134573253945f, a1 = -15.350567286626973f;
        const float delta = fabsf(a0 + (float)c * ((a1 - a0) / 1023.f));
        float* kdst = KF + (size_t)(ord * 1024 + c) * 16384;
        float sabs = 0.f;
#pragma unroll 1
        for (int mt = wv; mt < 256; mt += 8) {
            const float* hp = H2 + (size_t)(mt * 16 + fr) * 64 + fq * 8;
            const f32x4 h0 = *(const f32x4*)hp, h1 = *(const f32x4*)(hp + 4), h2 = *(const f32x4*)(hp + 32), h3 = *(const f32x4*)(hp + 36);
            u32x4 xh0, xl0, xh1, xl1; split8(h0, h1, xh0, xl0); split8(h2, h3, xh1, xl1);
            f32x4 acc = (f32x4){0.f, 0.f, 0.f, 0.f};
            acc = MK_MFMA(xh0, yh[0], acc); acc = MK_MFMA(xh0, yl[0], acc); acc = MK_MFMA(xl0, yh[0], acc);
            acc = MK_MFMA(xh1, yh[1], acc); acc = MK_MFMA(xh1, yl[1], acc); acc = MK_MFMA(xl1, yh[1], acc);
            const int t0 = mt * 16 + fq * 4; float v[4];
#pragma unroll
            for (int jj = 0; jj < 4; ++jj) { v[jj] = acc[jj] * expf(-((float)(t0 + jj) * (1.f / 4096.f)) * delta); sabs += fabsf(v[jj]); }
            if (dr == 0) *(f32x4*)(kdst + t0) = (f32x4){v[0], v[1], v[2], v[3]};
            else {
#pragma unroll
                for (int jj = 0; jj < 4; ++jj) if (t0 + jj > 0) kdst[8192 - t0 - jj] = v[jj]; }
        }
        sabs += __shfl_xor(sabs, 16); sabs += __shfl_xor(sabs, 32);
        __syncthreads();
        if (lane < 16) sRed[wv * 16 + lane] = sabs;
        if (tid < 8) KF[(size_t)((tid & 1) * 1024 + c0 + (tid >> 1)) * 16384 + 4096] = 0.f;
        asm volatile("s_waitcnt vmcnt(0)" ::: "memory");
        __syncthreads();
        float kv0[16], kv1[16];
#pragma unroll 1
        for (int chn = 0; chn < 4; ++chn) {
            const int n0 = chn * 4;
            float nr0 = 0.f, nr1 = 0.f;
#pragma unroll
            for (int w = 0; w < 8; ++w) { nr0 += sRed[w * 16 + n0] + sRed[w * 16 + n0 + 1]; nr1 += sRed[w * 16 + n0 + 2] + sRed[w * 16 + n0 + 3]; }
            float* kb0 = KF + (size_t)(c0 + chn) * 16384; float* kb1 = KF + (size_t)(1024 + c0 + chn) * 16384;
            if (chn == 0) {
#pragma unroll
                for (int u = 0; u < 16; ++u) { kv0[u] = __hip_atomic_load(kb0 + tid + 512 * u, __ATOMIC_RELAXED, __HIP_MEMORY_SCOPE_AGENT); kv1[u] = __hip_atomic_load(kb1 + tid + 512 * u, __ATOMIC_RELAXED, __HIP_MEMORY_SCOPE_AGENT); } }
#pragma unroll
            for (int u = 0; u < 16; ++u) X[xi(tid + 512 * u)] = (f32x2){kv0[u], kv1[u]};
            if (chn < 3) {
#pragma unroll
                for (int u = 0; u < 16; ++u) { kv0[u] = __hip_atomic_load(kb0 + 16384 + tid + 512 * u, __ATOMIC_RELAXED, __HIP_MEMORY_SCOPE_AGENT); kv1[u] = __hip_atomic_load(kb1 + 16384 + tid + 512 * u, __ATOMIC_RELAXED, __HIP_MEMORY_SCOPE_AGENT); } }
            __syncthreads();
            fft_fwd3(X, TW, tid);
#pragma unroll
            for (int u = 0; u < 8; ++u) { const int i = 2 * (tid + 512 * u); const f32x4 vv = *(const f32x4*)(X + xi(i));
                *(f32x4*)(X + xi(i)) = (f32x4){vv.x + vv.z, vv.y + vv.w, vv.x - vv.z, vv.y - vv.w}; }
            __syncthreads();
            const float sc0 = 0.5f / (nr0 * 8192.f), sc1 = 0.5f / (nr1 * 8192.f);
            f32x2* d0 = (f32x2*)kb0; f32x2* d1 = (f32x2*)kb1;
#pragma unroll
            for (int u = 0; u < 16; ++u) { const int pidx = tid + 512 * u;
                const int f = (int)(__brev((unsigned)pidx) >> 19), fp = (8192 - f) & 8191, pp = (int)(__brev((unsigned)fp) >> 19);
                const f32x2 Z = X[xi(pidx)], Zp = X[xi(pp)];
                d0[pidx] = (f32x2){(Z.x + Zp.x) * sc0, (Z.y - Zp.y) * sc0};
                d1[pidx] = (f32x2){(Z.y + Zp.y) * sc1, (Zp.x - Z.x) * sc1}; }
            __syncthreads();
        }
    }
}
__device__ __forceinline__ void unpack8(const u32x4 x, float* d) { d[0] = bflo(x.x); d[1] = bfhi(x.x); d[2] = bflo(x.y); d[3] = bfhi(x.y); d[4] = bflo(x.z); d[5] = bfhi(x.z); d[6] = bflo(x.w); d[7] = bfhi(x.w); }
__device__ __forceinline__ void conv8(const u32x4 x, float w0, float w1, float w2, float bi, float* y) {
    const int l8 = threadIdx.x & 7;
    const unsigned up = __shfl_up(x.w, 1), dn = __shfl_down(x.x, 1);
    const float left = l8 == 0 ? 0.f : bfhi(up), right = l8 == 7 ? 0.f : bflo(dn);
    float v[8]; unpack8(x, v);
    y[0] = w0 * left + w1 * v[0] + w2 * v[1] + bi;
#pragma unroll
    for (int e = 1; e < 7; ++e) y[e] = w0 * v[e - 1] + w1 * v[e] + w2 * v[e + 1] + bi;
    y[7] = w0 * v[6] + w1 * v[7] + w2 * right + bi;
}
__device__ __forceinline__ void phase_hy_main(const bf16_t* HYT, bf16_t* Z2T, const f32x2* KFS, const float* hy_bias, const float* cw, const float* cbias, unsigned char* smem, int tid, int vb) {
    f32x2* X = (f32x2*)smem; f32x2* TW = (f32x2*)(smem + XSZ_BYTES); f32x2* Z1 = (f32x2*)(smem + XSZ_BYTES + 16384);
    tw_init(TW, tid);
    const int t0 = tid * 8;
    u32x4 nv0, nv1, nx1a, nx1b, nx2a, nx2b;
    nv0 = nv1 = nx1a = nx1b = nx2a = nx2b = (u32x4){0u, 0u, 0u, 0u};
#define HYM_LOAD(it_) do { const int c_ = (it_) >> 1, b0_ = ((it_) & 1) * 2; \
        const bf16_t* v_ = HYT + ((size_t)c_ * 4 + b0_) * 4096 + t0; const bf16_t* x1_ = HYT + ((size_t)(1024 + c_) * 4 + b0_) * 4096 + t0; const bf16_t* x2_ = HYT + ((size_t)(2048 + c_) * 4 + b0_) * 4096 + t0; \
        nv0 = *(const u32x4*)v_; nv1 = *(const u32x4*)(v_ + 4096); nx1a = *(const u32x4*)x1_; nx1b = *(const u32x4*)(x1_ + 4096); nx2a = *(const u32x4*)x2_; nx2b = *(const u32x4*)(x2_ + 4096); } while (0)
    int item = vb;
    if (item < 2048) HYM_LOAD(item);
    for (; item < 2048; item += gridDim.x) {
        const int c = item >> 1, b0 = (item & 1) * 2;
        bf16_t* z0 = Z2T + ((size_t)c * 4 + b0) * 4096 + t0;
        const float bias1 = hy_bias[c], bias2 = hy_bias[1024 + c];
        const u32x4 rx1a = nx1a, rx1b = nx1b, rx2a = nx2a, rx2b = nx2b;
        const float cv0 = cw[c], cv1 = cw[3072 + c], cv2 = cw[6144 + c], cvb = cbias[c];
        const float c10 = cw[1024 + c], c11 = cw[3072 + 1024 + c], c12 = cw[6144 + 1024 + c], c1b = cbias[1024 + c];
        const float c20 = cw[2048 + c], c21 = cw[3072 + 2048 + c], c22 = cw[6144 + 2048 + c], c2b = cbias[2048 + c];
        float va[8], vb[8];
        conv8(nv0, cv0, cv1, cv2, cvb, va); conv8(nv1, cv0, cv1, cv2, cvb, vb);
        __syncthreads();
#pragma unroll
        for (int e = 0; e < 8; ++e) { X[xi(t0 + e)] = (f32x2){va[e], vb[e]}; X[xi(4096 + t0 + e)] = (f32x2){0.f, 0.f}; }
        __syncthreads();
        { f32x4 kk[8]; FFT_KLOAD(kk, KFS + (size_t)c * 8192);
          fft_fwd3(X, TW, tid);
          fft_mid(X, kk, tid); }
        fft_inv3(X, TW, tid);
        { float xa[8], xb[8]; conv8(rx1a, c10, c11, c12, c1b, xa); conv8(rx1b, c10, c11, c12, c1b, xb);
#pragma unroll
          for (int e = 0; e < 8; ++e) { const f32x2 y = X[xi(t0 + e)]; const f32x2 z = (f32x2){xa[e] * (y.x + va[e] * bias1), xb[e] * (y.y + vb[e] * bias1)};
              Z1[t0 + e] = z; X[xi(t0 + e)] = z; X[xi(4096 + t0 + e)] = (f32x2){0.f, 0.f}; } }
        if (item + (int)gridDim.x < 2048) HYM_LOAD(item + (int)gridDim.x);
        __syncthreads();
        { f32x4 kk[8]; FFT_KLOAD(kk, KFS + (size_t)(1024 + c) * 8192);
          fft_fwd3(X, TW, tid);
          fft_mid(X, kk, tid); }
        fft_inv3(X, TW, tid);
        { float xa[8], xb[8], ra[8], rb[8]; conv8(rx2a, c20, c21, c22, c2b, xa); conv8(rx2b, c20, c21, c22, c2b, xb);
#pragma unroll
          for (int e = 0; e < 8; ++e) { const f32x2 y = X[xi(t0 + e)], z = Z1[t0 + e]; ra[e] = xa[e] * (y.x + z.x * bias2); rb[e] = xb[e] * (y.y + z.y * bias2); }
          u32x4 w; w.x = pk2(ra[0], ra[1]); w.y = pk2(ra[2], ra[3]); w.z = pk2(ra[4], ra[5]); w.w = pk2(ra[6], ra[7]); *(u32x4*)z0 = w;
          w.x = pk2(rb[0], rb[1]); w.y = pk2(rb[2], rb[3]); w.z = pk2(rb[4], rb[5]); w.w = pk2(rb[6], rb[7]); *(u32x4*)(z0 + 4096) = w; }
    }
#undef HYM_LOAD
}
__device__ __forceinline__ void phase_hy_tout(const bf16_t* HYT, bf16_t* Z2, unsigned char* smem, int tid) {
    unsigned short* sT = (unsigned short*)smem;
    constexpr int NIT = 4 * 64 * 16;
    const int j = tid >> 3, part = tid & 7;
    u32x4 xn = (u32x4){0u, 0u, 0u, 0u};
#define TOUT_LOAD(it_) do { const int cbk_ = (it_) & 15, tb_ = ((it_) >> 4) & 63, b_ = (it_) >> 10; \
        xn = *(const u32x4*)(HYT + ((size_t)(cbk_ * 64 + j) * 4 + b_) * 4096 + tb_ * 64 + part * 8); } while (0)
    int item = blockIdx.x;
    if (item < NIT) TOUT_LOAD(item);
    for (; item < NIT; item += gridDim.x) {
        const int cbk = item & 15, tb = (item >> 4) & 63, b = item >> 10;
        const u32x4 x = xn;
        if (item + (int)gridDim.x < NIT) TOUT_LOAD(item + (int)gridDim.x);
        *(u32x4*)(sT + j * 72 + part * 8) = x;
        __syncthreads();
        { const int i = tid >> 3; unsigned short r[8];
#pragma unroll
          for (int jj = 0; jj < 8; ++jj) r[jj] = sT[(part * 8 + jj) * 72 + i];
          u32x4 w; w.x = r[0] | ((unsigned)r[1] << 16); w.y = r[2] | ((unsigned)r[3] << 16); w.z = r[4] | ((unsigned)r[5] << 16); w.w = r[6] | ((unsigned)r[7] << 16);
          *(u32x4*)(Z2 + (size_t)(b * SEQ + tb * 64 + i) * 1024 + cbk * 64 + part * 8) = w; }
        __syncthreads();
    }
#undef TOUT_LOAD
}

constexpr int N_PHASES = 18;
__global__ void __launch_bounds__(512, 2) mk_fwd(Args a) {
    extern __shared__ __attribute__((aligned(16))) unsigned char smem[];
    const int tid = threadIdx.x, lane = tid & 63, wv = tid >> 6;
    const int G = gridDim.x, bid = blockIdx.x;
    const int gw = bid * 8 + wv, ngw = G * 8, gtid = bid * 512 + tid, ngt = G * 512;
    unsigned char* ws = a.ws;
    const float* x = a.in[0]; const float* ctx = a.in[2]; const float* norm_g = a.in[6];
    float* out = a.out;
    float* MOD = (float*)(ws + OFF_MOD); float* H2 = (float*)(ws + OFF_H2); float* HC = (float*)(ws + OFF_HC); float* ABF = (float*)(ws + OFF_ABF);
    float* Gd = (float*)(ws + OFF_G); float* BETA = (float*)(ws + OFF_BETA);
    bf16_t* XN = (bf16_t*)(ws + OFF_XN); bf16_t* WA = (bf16_t*)(ws + OFF_WA); bf16_t* WAD = (bf16_t*)(ws + OFF_WA_D); bf16_t* WB = (bf16_t*)(ws + OFF_WB);
    bf16_t* ACT = (bf16_t*)(ws + OFF_ACT); bf16_t* PH = (bf16_t*)(ws + OFF_PH); bf16_t* PQKV = (bf16_t*)(ws + OFF_PQKV); bf16_t* PB = (bf16_t*)(ws + OFF_PB);
    bf16_t* Ob = (bf16_t*)(ws + OFF_O); bf16_t* OG = (bf16_t*)(ws + OFF_OG); bf16_t* Z2T = (bf16_t*)(ws + OFF_Z2T);
    bf16_t* Ub = (bf16_t*)(ws + OFF_U); bf16_t* Wb = (bf16_t*)(ws + OFF_W); bf16_t* QKb = (bf16_t*)(ws + OFF_QK); float* GC = (float*)(ws + OFF_GC);
    f32x2* KFS = (f32x2*)(ws + OFF_KFS); bf16_t* HYT = (bf16_t*)(ws + OFF_HYT); bf16_t* Z2 = (bf16_t*)(ws + OFF_Z2); float* TMP = (float*)(ws + OFF_TMP);
    bf16_t* WHY = (bf16_t*)(ws + OFF_WHY); bf16_t* WGD = (bf16_t*)(ws + OFF_WGD); bf16_t* WO = (bf16_t*)(ws + OFF_WO);
    PG8_LAS unsigned char* lds = (PG8_LAS unsigned char*)smem;
    const int lo = a.ph_lo, hi = a.ph_hi;
    const int vcu = (G % 8 == 0) ? (bid % 8) * (G / 8) + bid / 8 : bid;
#ifndef PH_MASK
#define PH_MASK 0x3ffff
#endif
#define IN(k) (((PH_MASK >> (k)) & 1) && lo <= (k) && (k) < hi)
    XcdBarrier xb; xb.bar = (unsigned*)(ws + OFF_BAR); xb.x = 0; xb.st = (volatile LAS unsigned*)(lds + LDS_BYTES - 16);
    if (hi - lo > 1) { if (tid < 4) xb.st[tid] = 0u; __syncthreads(); xb = xcd_barrier_post((unsigned*)(ws + OFF_BAR), (volatile LAS unsigned*)(lds + LDS_BYTES - 16)); }
#define SEAM(k) do { if ((k) + 1 < hi) { if ((k) == 0) cg::this_grid().sync(); else xcd_barrier(xb); } } while (0)

    if (IN(0)) {
        phase_mod(a.in[1], a.in[3], a.in[4], a.in[5], MOD, smem, tid);
        phase_h2(a.in[14], a.in[15], a.in[16], a.in[17], a.in[19], H2, gw, ngw, lane);
        __syncthreads();
        float* scr = (float*)(smem + wv * CONV_SCR);
        constexpr int I1 = 32 * 176, I2 = 88 * 32, I3 = 32 * 180;
        for (int it = gw; it < I1 + I2 + I3; it += ngw) {
            if (it < I1) conv_matrix(a.in[7], D, 2 * FF, WA, 2 * FF, 1, it, scr, lane);
            else if (it < I1 + I2) conv_matrix(a.in[8], FF, D, WAD, D, 0, it - I1, scr, lane);
            else conv_matrix(a.in[11], D, 11296, WB, NIN, 2, it - I1 - I2, scr, lane);
        }
        SEAM(0);
    }
    if (IN(1)) {
        for (int r = gw; r < MT; r += ngw) { const bool lat = r < ML; const int bm = lat ? (r >> 12) : 4;
            const float* src = lat ? x + (size_t)r * D : ctx + (size_t)(r - ML) * D; const float* m = MOD + (size_t)bm * NMOD;
            norm_ada_row(src, norm_g, m, m + D, XN + (size_t)r * D, lane); }
        SEAM(1);
    }
    if (IN(2)) {
        { pg8::Gemm g{XN, WA, ML, 2 * FF, D, D, 0}; pg8::StaticOrder S; S.init(ML, 2 * FF, G, bid);
          EpiSwiglu E{ACT, FF};
          pg8::gemm_phase<EpiSwiglu, pg8::StaticOrder>(lds, g, S, E, nullptr); }
        { pg8::Gemm g{XN + (size_t)ML * D, WA, MC, 2 * FF, D, D, 0}; pg8::StaticOrder S; S.init(MC, 2 * FF, G, bid);
          EpiSwiglu E{ACT + (size_t)ML * FF, FF};
          pg8::gemm_phase<EpiSwiglu, pg8::StaticOrder>(lds, g, S, E, nullptr); }
        SEAM(2);
    }
    if (IN(3)) {
        { pg8::Gemm g{ACT, WAD, ML, D, FF, FF, 0}; pg8::StaticOrder S; S.init(ML, D, G, bid);
          EpiResid E{x, ctx, out, HC, MOD + 2 * D, 0.5f};
          pg8::gemm_phase<EpiResid, pg8::StaticOrder>(lds, g, S, E, nullptr); }
        { pg8::Gemm g{ACT + (size_t)ML * FF, WAD, MC, D, FF / 4, FF, (size_t)(FF / 4) * 2}; CtxSplitOrder S{G, bid};
          EpiCtxPart E{(float*)(ws + OFF_PB), MOD + (size_t)4 * NMOD + 2 * D, 0.5f};
          pg8::gemm_phase<EpiCtxPart, CtxSplitOrder>(lds, g, S, E, nullptr); }
        SEAM(3);
    }
    if (IN(4)) {
        for (int r = gw; r < MT; r += ngw) { const bool lat = r < ML; const int bm = lat ? (r >> 12) : 4;
            const float* m = MOD + (size_t)bm * NMOD;
            if (lat) norm_ada_row(out + (size_t)r * D, norm_g + D, m + 3 * D, m + 4 * D, XN + (size_t)r * D, lane);
            else norm_ada_row_ctx(ctx + (size_t)(r - ML) * D, (const float*)(ws + OFF_PB) + (size_t)(r - ML) * D, norm_g + D, m + 3 * D, m + 4 * D, XN + (size_t)r * D, lane); }
        SEAM(4);
    }
    if (IN(5)) {
        pg8::Gemm g{XN, WB, MT, NIN, D, D, 0}; WinOrder S; S.init(ML, NIN, G, bid);
        EpiWin E{PH, PQKV, PB, ABF};
        pg8::gemm_phase<EpiWin, WinOrder>(lds, g, S, E, nullptr);
        SEAM(5);
    }
    if (IN(6)) {
        phase_gbeta(ABF, a.in[23], a.in[24], Gd, BETA, gtid, ngt);
        phase_gdn_conv(PQKV, a.in[22], smem, tid);
        SEAM(6);
    }
    if (IN(7)) {
        phase_gdn_prep(PQKV, Gd, BETA, Ub, Wb, QKb, GC, smem, tid);
        SEAM(7);
    }
    if (IN(8)) {
        phase_scan(PQKV, Ub, Wb, QKb, GC, Ob, smem, tid, vcu);
        SEAM(8);
    }
    if (IN(9)) {
        const bool mem_first = ((bid >> 3) & 1) == 0;
        if (mem_first && (a.sub & 1)) phase_ogate(Ob, OG, PB, a.in[25], gw, ngw, lane);
        float* scr = (float*)(smem + wv * CONV_SCR);
        constexpr int I1 = 16 * 32, I2 = 16 * 32, I3 = 32 * 32;
        if (mem_first && (a.sub & 8)) { for (int it = gw; it < I1 + I2 + I3; it += ngw) {
            if (it < I1) conv_matrix(a.in[21], 1024, D, WHY, D, 0, it, scr, lane);
            else if (it < I1 + I2) conv_matrix(a.in[26], 1024, D, WGD, D, 0, it - I1, scr, lane);
            else conv_matrix(a.in[27], D, D, WO, D, 0, it - I1 - I2, scr, lane); } }
        __syncthreads();
        if (a.sub & 4) phase_hy_filt(H2, a.in[18], KFS, smem, tid);
        __syncthreads();
        if (!mem_first && (a.sub & 8)) { for (int it = gw; it < I1 + I2 + I3; it += ngw) {
            if (it < I1) conv_matrix(a.in[21], 1024, D, WHY, D, 0, it, scr, lane);
            else if (it < I1 + I2) conv_matrix(a.in[26], 1024, D, WGD, D, 0, it - I1, scr, lane);
            else conv_matrix(a.in[27], D, D, WO, D, 0, it - I1 - I2, scr, lane); } }
        if (!mem_first && (a.sub & 1)) phase_ogate(Ob, OG, PB, a.in[25], gw, ngw, lane);
        SEAM(9);
    }
    if (IN(10)) {
        phase_hy_main(HYT, Z2T, KFS, a.in[20], a.in[12], a.in[13], smem, tid, vcu);
        SEAM(10);
    }
    if (IN(11)) {
        phase_hy_tout(Z2T, Z2, smem, tid);
        __syncthreads();
        float* scr = (float*)(smem + wv * CONV_SCR);
        constexpr int I1 = 32 * 176, I2 = 88 * 32;
        for (int it = gw; it < I1 + I2; it += ngw) {
            if (it < I1) conv_matrix(a.in[9], D, 2 * FF, WA, 2 * FF, 1, it, scr, lane);
            else conv_matrix(a.in[10], FF, D, WAD, D, 0, it - I1, scr, lane);
        }
        SEAM(11);
    }
    if (IN(12)) {
        { pg8::Gemm g{Z2, WHY, ML, D, 1024, 1024, 0}; pg8::StaticOrder S; S.init(ML, D, G, bid);
          EpiMerge<0> E{PB + 1024, TMP, nullptr};
          pg8::gemm_phase<EpiMerge<0>, pg8::StaticOrder>(lds, g, S, E, nullptr); }
        { pg8::Gemm g{OG, WGD, ML, D, 1024, 1024, 0}; pg8::StaticOrder S; S.init(ML, D, G, bid);
          EpiMerge<1> E{PB + 1024 + 2048, TMP, XN};
          pg8::gemm_phase<EpiMerge<1>, pg8::StaticOrder>(lds, g, S, E, nullptr); }
        SEAM(12);
    }
    if (IN(13)) {
        pg8::Gemm g{XN, WO, ML, D, D, D, 0}; pg8::StaticOrder S; S.init(ML, D, G, bid);
        EpiResid E{out, out, out, out, MOD + 5 * D, 1.0f};
        pg8::gemm_phase<EpiResid, pg8::StaticOrder>(lds, g, S, E, nullptr);
        SEAM(13);
    }
    if (IN(14)) {
        for (int r = gw; r < ML; r += ngw) { const float* m = MOD + (size_t)(r >> 12) * NMOD;
            norm_ada_row(out + (size_t)r * D, norm_g + 2 * D, m + 6 * D, m + 7 * D, XN + (size_t)r * D, lane); }
        SEAM(14);
    }
    if (IN(15)) {
        pg8::Gemm g{XN, WA, ML, 2 * FF, D, D, 0}; pg8::StaticOrder S; S.init(ML, 2 * FF, G, bid);
        EpiSwiglu E{ACT, FF};
        pg8::gemm_phase<EpiSwiglu, pg8::StaticOrder>(lds, g, S, E, nullptr);
        SEAM(15);
    }
    if (IN(16)) {
        pg8::Gemm g{ACT, WAD, ML, D, FF, FF, 0}; pg8::StaticOrder S; S.init(ML, D, G, bid);
        EpiResid E{out, out, out, out, MOD + 8 * D, 0.5f};
        pg8::gemm_phase<EpiResid, pg8::StaticOrder>(lds, g, S, E, nullptr);
        SEAM(16);
    }
    if (IN(17)) {
        for (int r = gw; r < ML; r += ngw) final_norm_row(out + (size_t)r * D, a.in[28], lane);
    }
#undef IN
#undef SEAM
}
}

extern "C" void kernel_launch(void* const* d_in, const int* in_sizes, int n_in, void* d_out, int out_size, void* d_ws, size_t ws_size, hipStream_t stream) {
    static int grid = 0;
    if (grid == 0) {
        int dev = 0, cus = 0, per_cu = 0;
        if (hipGetDevice(&dev) != hipSuccess || hipDeviceGetAttribute(&cus, hipDeviceAttributeMultiprocessorCount, dev) != hipSuccess || cus <= 0) { fprintf(stderr, "kernel_launch: device query failed\n"); grid = -1; return; }
        if (hipFuncSetAttribute((const void*)mk::mk_fwd, hipFuncAttributeMaxDynamicSharedMemorySize, mk::LDS_BYTES) != hipSuccess) { fprintf(stderr, "kernel_launch: hipFuncSetAttribute failed\n"); grid = -1; return; }
        if (hipOccupancyMaxActiveBlocksPerMultiprocessor(&per_cu, (const void*)mk::mk_fwd, 512, mk::LDS_BYTES) != hipSuccess || per_cu < 1) { fprintf(stderr, "kernel_launch: occupancy query gave %d\n", per_cu); per_cu = 1; }
        (void)hipGetLastError();
        grid = cus;
    }
    if (grid < 0) return;
    if (n_in != 29 || ws_size < mk::WS_END) { fprintf(stderr, "kernel_launch: n_in %d ws %zu (need %zu)\n", n_in, ws_size, (size_t)mk::WS_END); return; }
    mk::Args a{};
    for (int i = 0; i < 29; ++i) a.in[i] = (const float*)d_in[i];
    a.out = (float*)d_out; a.ws = (unsigned char*)d_ws; a.sub = 15;
#if MK_MULTI
#ifndef REPEAT_MASK
#define REPEAT_MASK 0
#endif
    for (int ph = 0; ph < mk::N_PHASES; ++ph) { a.ph_lo = ph; a.ph_hi = ph + 1;
        const int reps = ((REPEAT_MASK >> ph) & 1) ? 2 : 1;
        for (int r = 0; r < reps; ++r) {
#ifdef REPEAT_SUB
            a.sub = (r == 0) ? 15 : REPEAT_SUB;
#endif
            hipLaunchKernelGGL(mk::mk_fwd, dim3(grid), dim3(512), mk::LDS_BYTES, stream, a); } }
#else
    a.ph_lo = 0; a.ph_hi = mk::N_PHASES;
    if (hipMemsetAsync((char*)d_ws + mk::OFF_BAR, 0, (size_t)XCD_BAR_WORDS * 4, stream) != hipSuccess) { fprintf(stderr, "kernel_launch: memset of the barrier words failed\n"); return; }
    void* args[] = {&a};
    hipError_t e = hipLaunchCooperativeKernel((const void*)mk::mk_fwd, dim3(grid), dim3(512), args, mk::LDS_BYTES, stream);
    if (e != hipSuccess) fprintf(stderr, "kernel_launch: cooperative launch failed: %s (grid %d)\n", hipGetErrorString(e), grid);
#endif
}
```

```cpp
#include <hip/hip_runtime.h>
#include <hip/hip_cooperative_groups.h>
#include <cstdio>
#ifndef MK_MULTI
#define MK_MULTI 0
#endif
namespace pg8 {
#define PG8_LAS __attribute__((address_space(3)))
typedef unsigned short bf16_t;
typedef short bf16x8 __attribute__((ext_vector_type(8)));
typedef float f32x4 __attribute__((ext_vector_type(4)));
typedef unsigned u32x4 __attribute__((ext_vector_type(4)));
constexpr int BM = 256, BK = 64, HALF = 128, HTB = HALF * BK * 2  , STAGE_BYTES = 8 * HTB, NXCD = 8, WGM = 8;

__host__ __device__ __forceinline__ int lds_byte(int r, int c) { const int st = (r >> 4) * 2 + (c >> 5), rr = r & 15, cc = c & 31, ob = rr * 64 + cc * 2; return st * 1024 + (ob ^ (((ob >> 9) & 1) << 5)); }
__host__ __device__ __forceinline__ void stage_rc(int b, int& R, int& C) { const int st = b / 1024, sb = b % 1024, swz = sb ^ (((sb >> 9) & 1) << 5); R = (st >> 1) * 16 + swz / 64; C = (st & 1) * 32 + (swz % 64) / 2; }
__host__ __device__ __forceinline__ int perm32(int rho) { const int n = rho >> 4, i = rho & 15; return 8 * (i >> 2) + 4 * n + (i & 3); }

struct Unit { int pm, pn, kq; };
struct Gemm { const bf16_t* A; const bf16_t* Bt; int M, N, K; int ld; size_t ksub; };

struct StaticOrder {
    int nM, nN, nwg, G, c;
    __host__ __device__ void init(int M, int N, int G_, int c_) { nM = M / BM; nN = N / BM; nwg = nM * nN; G = G_; c = c_; }
    __host__ __device__ bool next(int i, Unit& u) const {
        const long L = (long)i * G + c; if (L >= nwg) return false;
        int wgid = (int)L; { const int q = nwg / NXCD, r = nwg % NXCD, xcd = wgid % NXCD, off = wgid / NXCD; wgid = (xcd < r ? xcd * (q + 1) : r * (q + 1) + (xcd - r) * q) + off; }
        const int nig = WGM * nN, gid = wgid / nig, fm = gid * WGM, gsz = (nM - fm) < WGM ? (nM - fm) : WGM;
        u.pm = fm + ((wgid % nig) % gsz); u.pn = (wgid % nig) / gsz; u.kq = 0; return true;
    }
    __device__ __forceinline__ void a_ready(const Unit&) const {}
    __device__ __forceinline__ void done(const Unit&) const {}
};
struct CountedOrder : StaticOrder {
    const unsigned* ready; unsigned need; unsigned* tmo;
    __device__ __forceinline__ void a_ready(const Unit& u) const {
        if (threadIdx.x < 64) {
            const unsigned long long t0 = __builtin_amdgcn_s_memrealtime(); unsigned polls = 0;
            while ((unsigned)__builtin_amdgcn_readfirstlane(__hip_atomic_load(ready + 64 * u.pm, __ATOMIC_RELAXED, __HIP_MEMORY_SCOPE_AGENT)) < need) {
                if ((++polls & 255u) == 0u && __builtin_amdgcn_readfirstlane(__hip_atomic_load(tmo, __ATOMIC_RELAXED, __HIP_MEMORY_SCOPE_AGENT)) != 0u) break;
                if (__builtin_amdgcn_s_memrealtime() - t0 > 2000000ull) {
                    if (threadIdx.x == 0) { unsigned expect = 0u; __hip_atomic_compare_exchange_strong(tmo + 1, &expect, 0x600u | (unsigned)(u.pm & 0xff), __ATOMIC_RELAXED, __ATOMIC_RELAXED, __HIP_MEMORY_SCOPE_AGENT); __hip_atomic_store(tmo, 1u, __ATOMIC_RELAXED, __HIP_MEMORY_SCOPE_AGENT); }
                    break; }
                __builtin_amdgcn_s_sleep(2); }
            __builtin_amdgcn_fence(__ATOMIC_ACQUIRE, "agent");
            asm volatile("s_waitcnt vmcnt(0)" ::: "memory");
        }
#if !defined(BROKEN_HOOK_NO_BARRIER)
        asm volatile("" ::: "memory"); __builtin_amdgcn_s_barrier(); asm volatile("" ::: "memory");
#endif
    }
};

__device__ __forceinline__ unsigned cvt_pk_bf16(float lo, float hi) { unsigned r; asm volatile("v_cvt_pk_bf16_f32 %0, %1, %2" : "=v"(r) : "v"(lo), "v"(hi)); return r; }
typedef float f32x2 __attribute__((ext_vector_type(2)));
__device__ __forceinline__ f32x2 gelu_pk(f32x2 v) {
    const f32x2 av = __builtin_elementwise_abs(v), d = av * 0.2316418882f + 1.0f;
    f32x2 t; t.x = __builtin_amdgcn_rcpf(d.x); t.y = __builtin_amdgcn_rcpf(d.y);
    f32x2 q = t * 0.5307027145f + (-0.7265760135f); q = q * t + 0.7107068705f; q = q * t + (-0.142248368f); q = q * t + 0.127414796f; q = q * t;
    const f32x2 s = (v * v) * (-0.72134752044f);
    f32x2 e; e.x = __builtin_amdgcn_exp2f(s.x); e.y = __builtin_amdgcn_exp2f(s.y);
    const f32x2 m = v * (q * e), r = v - m;
    f32x2 o; o.x = v.x < 0.f ? m.x : r.x; o.y = v.y < 0.f ? m.y : r.y; return o;
}

struct EpiF32 {
    static constexpr bool PERM = false, AFTER_DRAIN = false;
    float* C; int ldc; const float* bias;
    __device__ __forceinline__ void operator()(const f32x4 (&acc)[2][2][4][2], const Unit& u, int wr, int wc, int fr, int fq) const {
        const int row0 = u.pm * BM + wr * 64 + fr, col0 = u.pn * BM + wc * 32 + 4 * fq;
        f32x4 bv[2][2];
#pragma unroll
        for (int bj = 0; bj < 2; ++bj)
#pragma unroll
            for (int n = 0; n < 2; ++n) bv[bj][n] = bias ? *(const f32x4*)(bias + col0 + bj * HALF + n * 16) : (f32x4){0.f, 0.f, 0.f, 0.f};
#pragma unroll
        for (int ai = 0; ai < 2; ++ai)
#pragma unroll
            for (int m = 0; m < 4; ++m) { float* rowp = C + (size_t)(row0 + ai * HALF + m * 16) * ldc + col0;
#pragma unroll
                for (int bj = 0; bj < 2; ++bj)
#pragma unroll
                    for (int n = 0; n < 2; ++n) *(f32x4*)(rowp + bj * HALF + n * 16) = acc[ai][bj][m][n] + bv[bj][n]; }
    }
};
template <int ACT  > struct EpiBf16 {
    static constexpr bool PERM = true, AFTER_DRAIN = false;
    bf16_t* O; int ldc; const float* bias; int split_cols; size_t split_stride;
    __device__ __forceinline__ void operator()(const f32x4 (&acc)[2][2][4][2], const Unit& u, int wr, int wc, int fr, int fq) const {
        const int row0 = u.pm * BM + wr * 64 + fr; int colt = u.pn * BM; bf16_t* base = O;
        if (split_cols) { const int t = colt / split_cols; base += (size_t)t * split_stride; colt -= t * split_cols; }
        const int col0 = colt + wc * 32 + 8 * fq, bcol0 = u.pn * BM + wc * 32 + 8 * fq;
        f32x4 bv[2][2];
#pragma unroll
        for (int bj = 0; bj < 2; ++bj)
#pragma unroll
            for (int n = 0; n < 2; ++n) bv[bj][n] = bias ? *(const f32x4*)(bias + bcol0 + bj * HALF + 4 * n) : (f32x4){0.f, 0.f, 0.f, 0.f};
#pragma unroll
        for (int ai = 0; ai < 2; ++ai)
#pragma unroll
            for (int m = 0; m < 4; ++m) { bf16_t* rowp = base + (size_t)(row0 + ai * HALF + m * 16) * ldc + col0;
#pragma unroll
                for (int bj = 0; bj < 2; ++bj) { f32x4 v0 = acc[ai][bj][m][0] + bv[bj][0], v1 = acc[ai][bj][m][1] + bv[bj][1];
                    if (ACT == 1) { f32x2 a = gelu_pk((f32x2){v0[0], v0[1]}), b = gelu_pk((f32x2){v0[2], v0[3]}), c = gelu_pk((f32x2){v1[0], v1[1]}), d = gelu_pk((f32x2){v1[2], v1[3]});
                        v0 = (f32x4){a.x, a.y, b.x, b.y}; v1 = (f32x4){c.x, c.y, d.x, d.y}; }
                    if (ACT == 2) {
#pragma unroll
                        for (int j = 0; j < 4; ++j) { v0[j] = 0.5f * v0[j] * (1.0f + erff(v0[j] * 0.70710678f)); v1[j] = 0.5f * v1[j] * (1.0f + erff(v1[j] * 0.70710678f)); } }
                    u32x4 w; w.x = cvt_pk_bf16(v0[0], v0[1]); w.y = cvt_pk_bf16(v0[2], v0[3]); w.z = cvt_pk_bf16(v1[0], v1[1]); w.w = cvt_pk_bf16(v1[2], v1[3]);
                    *(u32x4*)(rowp + bj * HALF) = w; } }
    }
};

struct PanelStats {
    unsigned* xbuf;
    unsigned* cnt;
    unsigned* tmo;
    int ntn; float eps;
    unsigned code;
    __device__ __forceinline__ bool run(const f32x4 (&v)[2][2][4][2], const Unit& u, int wr, int wc, int fr, int fq, PG8_LAS unsigned char* lds, int wid, int lane) const {
        typedef float f32x2v __attribute__((ext_vector_type(2)));
        PG8_LAS f32x2v* P = (PG8_LAS f32x2v*)lds;
        PG8_LAS f32x2v* S = (PG8_LAS f32x2v*)(lds + 8192);
        PG8_LAS unsigned* flag = (PG8_LAS unsigned*)(lds + 8192 + 2048);
#pragma unroll
        for (int ai = 0; ai < 2; ++ai)
#pragma unroll
            for (int m = 0; m < 4; ++m) {
                float s = 0.f;
#pragma unroll
                for (int bj = 0; bj < 2; ++bj)
#pragma unroll
                    for (int n = 0; n < 2; ++n) { const f32x4 x = v[ai][bj][m][n]; s += (x[0] + x[1]) + (x[2] + x[3]); }
                s += __shfl_xor(s, 16); s += __shfl_xor(s, 32);
                const float mw = s * (1.0f / 64.0f); float q = 0.f;
#pragma unroll
                for (int bj = 0; bj < 2; ++bj)
#pragma unroll
                    for (int n = 0; n < 2; ++n) { const f32x4 d = v[ai][bj][m][n] - mw; q += (d[0] * d[0] + d[1] * d[1]) + (d[2] * d[2] + d[3] * d[3]); }
                q += __shfl_xor(q, 16); q += __shfl_xor(q, 32);
                if (fq == 0) P[(ai * HALF + wr * 64 + m * 16 + fr) * 4 + wc] = (f32x2v){mw, q};
            }
        asm volatile("s_waitcnt lgkmcnt(0)" ::: "memory"); __builtin_amdgcn_s_barrier(); asm volatile("" ::: "memory");
#if defined(BROKEN_NO_WAIT)
        if (blockIdx.x >= 64) { const long long t0 = clock64(); while (clock64() - t0 < 60000) __builtin_amdgcn_s_sleep(8); }
#endif
        const int row = wid * 32 + (lane & 31);
        if (lane < 32) {
            const f32x2v a = P[row * 4 + 0], b = P[row * 4 + 1], c = P[row * 4 + 2], d = P[row * 4 + 3];
            const float mt = (a.x + b.x + c.x + d.x) * 0.25f;
            const float da = a.x - mt, db = b.x - mt, dc = c.x - mt, dd = d.x - mt;
            const float m2 = (a.y + b.y) + (c.y + d.y) + 64.0f * ((da * da + db * db) + (dc * dc + dd * dd));
            unsigned long long* slot = (unsigned long long*)xbuf + ((size_t)(u.pm * BM + row) * 4 + u.pn);
            __hip_atomic_store(slot, ((unsigned long long)__float_as_uint(m2) << 32) | __float_as_uint(mt), __ATOMIC_RELAXED, __HIP_MEMORY_SCOPE_AGENT);
        }
        asm volatile("s_waitcnt vmcnt(0)" ::: "memory");
        if (lane == 0) __hip_atomic_fetch_add(cnt + 64 * u.pm, 1u, __ATOMIC_RELAXED, __HIP_MEMORY_SCOPE_AGENT);
        if (wid == 0) {
            bool dead = false; const unsigned long long t0 = __builtin_amdgcn_s_memrealtime(); const unsigned want = 8u * (unsigned)ntn;
            for (;;) {
#if defined(BROKEN_NO_WAIT)
                break;
#endif
                if ((unsigned)__builtin_amdgcn_readfirstlane(__hip_atomic_load(cnt + 64 * u.pm, __ATOMIC_RELAXED, __HIP_MEMORY_SCOPE_AGENT)) >= want) break;
                if (__builtin_amdgcn_s_memrealtime() - t0 > 2000000ull) {
                    if (lane == 0) { unsigned expect = 0u; __hip_atomic_compare_exchange_strong(tmo + 1, &expect, code | (unsigned)(u.pm & 0xff), __ATOMIC_RELAXED, __ATOMIC_RELAXED, __HIP_MEMORY_SCOPE_AGENT);
                                     __hip_atomic_store(tmo, 1u, __ATOMIC_RELAXED, __HIP_MEMORY_SCOPE_AGENT); }
                    dead = true; break; }
                __builtin_amdgcn_s_sleep(2);
            }
            __builtin_amdgcn_fence(__ATOMIC_ACQUIRE, "agent");
            if (lane == 0) flag[0] = dead ? 1u : 0u;
        }
        asm volatile("s_waitcnt vmcnt(0) lgkmcnt(0)" ::: "memory"); __builtin_amdgcn_s_barrier(); asm volatile("" ::: "memory");
        const bool bad = flag[0] != 0u;
        if (lane < 32) {
            const unsigned long long* slot = (const unsigned long long*)xbuf + (size_t)(u.pm * BM + row) * 4; float mt[4], m2[4]; float ms = 0.f;
#pragma unroll
            for (int t = 0; t < 4; ++t) { if (t < ntn) { const unsigned long long w = __hip_atomic_load(slot + t, __ATOMIC_RELAXED, __HIP_MEMORY_SCOPE_AGENT); mt[t] = __uint_as_float((unsigned)w); m2[t] = __uint_as_float((unsigned)(w >> 32)); } else { mt[t] = 0.f; m2[t] = 0.f; } ms += mt[t]; }
            const float mean = ms / (float)ntn; float q = 0.f;
#pragma unroll
            for (int t = 0; t < 4; ++t) if (t < ntn) { const float dm = mt[t] - mean; q += m2[t] + 256.0f * dm * dm; }
            S[row] = (f32x2v){mean, 1.0f / sqrtf(q / (256.0f * (float)ntn) + eps)};
        }
        asm volatile("s_waitcnt lgkmcnt(0)" ::: "memory"); __builtin_amdgcn_s_barrier(); asm volatile("" ::: "memory");
        return bad;
    }
};
struct EpiLnRes {
    static constexpr bool PERM = false, AFTER_DRAIN = true;
    const float* base; float* out; int ldc; const float* bias; PanelStats st; unsigned poison;
    __device__ __forceinline__ void refuse(size_t i0, size_t stride, int M, int N) const { const float q = __builtin_nanf(""); for (size_t i = i0; i < (size_t)M * N; i += stride) out[(i / N) * ldc + i % N] = q;
        if (i0 == 0) { unsigned expect = 0u; __hip_atomic_compare_exchange_strong(st.tmo + 1, &expect, 0x7f0u, __ATOMIC_RELAXED, __ATOMIC_RELAXED, __HIP_MEMORY_SCOPE_AGENT); __hip_atomic_store(st.tmo, 1u, __ATOMIC_RELAXED, __HIP_MEMORY_SCOPE_AGENT); } }
    __device__ __forceinline__ void fused(f32x4 (&acc)[2][2][4][2], const Unit& u, int wr, int wc, int fr, int fq, PG8_LAS unsigned char* lds, int wid, int lane) const {
        typedef float f32x2v __attribute__((ext_vector_type(2)));
        const PG8_LAS f32x2v* S = (const PG8_LAS f32x2v*)(lds + 8192);
        const int col0 = u.pn * BM + wc * 32 + 4 * fq;
#pragma unroll
        for (int bj = 0; bj < 2; ++bj)
#pragma unroll
            for (int n = 0; n < 2; ++n) { const f32x4 bv = bias ? *(const f32x4*)(bias + col0 + bj * HALF + n * 16) : (f32x4){0.f, 0.f, 0.f, 0.f};
#pragma unroll
                for (int ai = 0; ai < 2; ++ai)
#pragma unroll
                    for (int m = 0; m < 4; ++m) acc[ai][bj][m][n] += bv; }
        const bool bad = st.run(acc, u, wr, wc, fr, fq, lds, wid, lane) || poison != 0u;
        const float qnan = __builtin_nanf("");
#pragma unroll
        for (int ai = 0; ai < 2; ++ai)
#pragma unroll
            for (int m = 0; m < 4; ++m) { const int r = ai * HALF + wr * 64 + m * 16 + fr; const f32x2v sr = S[r]; const size_t off = (size_t)(u.pm * BM + r) * ldc + col0;
#pragma unroll
                for (int bj = 0; bj < 2; ++bj)
#pragma unroll
                    for (int n = 0; n < 2; ++n) { const f32x4 bs = *(const f32x4*)(base + off + bj * HALF + n * 16); f32x4 o = bs + (acc[ai][bj][m][n] - sr.x) * sr.y;
                        if (bad) o = (f32x4){qnan, qnan, qnan, qnan}; *(f32x4*)(out + off + bj * HALF + n * 16) = o; }
                asm volatile("" ::: "memory"); }
    }
};
struct EpiLnResLn {
    static constexpr bool PERM = false, AFTER_DRAIN = true;
    const float* base; float* out; bf16_t* xn; int ldc; const float* bias; PanelStats st1, st2; unsigned poison;
    __device__ __forceinline__ void refuse(size_t i0, size_t stride, int M, int N) const { const float q = __builtin_nanf(""); for (size_t i = i0; i < (size_t)M * N; i += stride) { const size_t o = (i / N) * ldc + i % N; out[o] = q; xn[o] = (bf16_t)0x7fc0u; }
        if (i0 == 0) { unsigned expect = 0u; __hip_atomic_compare_exchange_strong(st1.tmo + 1, &expect, 0x7f0u, __ATOMIC_RELAXED, __ATOMIC_RELAXED, __HIP_MEMORY_SCOPE_AGENT); __hip_atomic_store(st1.tmo, 1u, __ATOMIC_RELAXED, __HIP_MEMORY_SCOPE_AGENT); } }
    __device__ __forceinline__ void fused(f32x4 (&acc)[2][2][4][2], const Unit& u, int wr, int wc, int fr, int fq, PG8_LAS unsigned char* lds, int wid, int lane) const {
        typedef float f32x2v __attribute__((ext_vector_type(2))); typedef unsigned u32x2v __attribute__((ext_vector_type(2)));
        const PG8_LAS f32x2v* S = (const PG8_LAS f32x2v*)(lds + 8192);
        const int col0 = u.pn * BM + wc * 32 + 4 * fq;
#pragma unroll
        for (int bj = 0; bj < 2; ++bj)
#pragma unroll
            for (int n = 0; n < 2; ++n) { const f32x4 bv = bias ? *(const f32x4*)(bias + col0 + bj * HALF + n * 16) : (f32x4){0.f, 0.f, 0.f, 0.f};
#pragma unroll
                for (int ai = 0; ai < 2; ++ai)
#pragma unroll
                    for (int m = 0; m < 4; ++m) acc[ai][bj][m][n] += bv; }
        bool bad = st1.run(acc, u, wr, wc, fr, fq, lds, wid, lane) || poison != 0u;
        const float qnan = __builtin_nanf("");
#pragma unroll
        for (int ai = 0; ai < 2; ++ai)
#pragma unroll
            for (int m = 0; m < 4; ++m) { const int r = ai * HALF + wr * 64 + m * 16 + fr; const f32x2v sr = S[r]; const size_t off = (size_t)(u.pm * BM + r) * ldc + col0;
#pragma unroll
                for (int bj = 0; bj < 2; ++bj)
#pragma unroll
                    for (int n = 0; n < 2; ++n) { const f32x4 bs = *(const f32x4*)(base + off + bj * HALF + n * 16); acc[ai][bj][m][n] = bs + (acc[ai][bj][m][n] - sr.x) * sr.y; }
                asm volatile("" : "+v"(acc[ai][0][m][0]), "+v"(acc[ai][0][m][1]), "+v"(acc[ai][1][m][0]), "+v"(acc[ai][1][m][1]));
                if (m & 1) asm volatile("" ::: "memory"); }
        const bool bad1 = bad;
        bad = st2.run(acc, u, wr, wc, fr, fq, lds, wid, lane) || bad;
#pragma unroll
        for (int ai = 0; ai < 2; ++ai)
#pragma unroll
            for (int m = 0; m < 4; ++m) { const int r = ai * HALF + wr * 64 + m * 16 + fr; const f32x2v sr = S[r]; const size_t off = (size_t)(u.pm * BM + r) * ldc + col0;
#pragma unroll
                for (int bj = 0; bj < 2; ++bj)
#pragma unroll
                    for (int n = 0; n < 2; ++n) { const f32x4 x1 = acc[ai][bj][m][n]; *(f32x4*)(out + off + bj * HALF + n * 16) = bad1 ? (f32x4){qnan, qnan, qnan, qnan} : x1;
                        const f32x4 o = (x1 - sr.x) * sr.y; u32x2v w; w.x = cvt_pk_bf16(o[0], o[1]); w.y = cvt_pk_bf16(o[2], o[3]);
                        if (bad) { w.x = 0x7fc07fc0u; w.y = 0x7fc07fc0u; } *(u32x2v*)(xn + off + bj * HALF + n * 16) = w; }
                asm volatile("" ::: "memory"); }
    }
};

template <class Epi, class Sched, bool STAMP = false>
__device__ __forceinline__ void gemm_phase(PG8_LAS unsigned char* lds, const Gemm g, const Sched& S, const Epi& E, unsigned long long* stamps) {
    const int tid = threadIdx.x, wid = __builtin_amdgcn_readfirstlane(tid >> 6), lane = tid & 63, wr = wid >> 2, wc = wid & 3, fr = lane & 15, fq = lane >> 4;
    const int K = g.K, nt = K / BK, LD = g.ld;
    int ts_lo = 0, ts_hi = 0, nts = 0; const unsigned long long rt_entry = STAMP ? (unsigned long long)wall_clock64() : 0ull;
#define PG8_STAMP() do { if (STAMP && wid == 0 && nts < 64) { const unsigned long long _c = (unsigned long long)clock64(); \
        ts_lo = (lane == nts) ? (int)(unsigned)_c : ts_lo; ts_hi = (lane == nts) ? (int)(unsigned)(_c >> 32) : ts_hi; ++nts; } } while (0)
    PG8_STAMP();
    unsigned voffA[2], voffB[2];
#pragma unroll
    for (int i = 0; i < 2; ++i) { int R, C; stage_rc(tid * 16 + i * 8192, R, C); const int Rb = Epi::PERM ? ((R & ~31) + perm32(R & 31)) : R;
        voffA[i] = (unsigned)(R * LD + C) * 2u; voffB[i] = (unsigned)(Rb * LD + C) * 2u; }
    const size_t kstep = (size_t)(BK * 2);
    const size_t hstep = (size_t)HALF * LD * 2;
    const size_t tstep = 2 * hstep;
    const unsigned ldsw = (unsigned)wid * 1024u;
    const int aoff = lds_byte(wr * 64 + fr, fq * 8), boff = lds_byte(wc * 32 + fr, fq * 8);
#define PG8_SA(b, h) (((b) * 2 + (h)) * HTB)
#define PG8_SB(b, h) ((4 + (b) * 2 + (h)) * HTB)
#define PG8_STAGE(bufoff, gbase, voff) do { _Pragma("unroll") for (int _i = 0; _i < 2; ++_i) \
        __builtin_amdgcn_global_load_lds((const unsigned*)((const char*)(gbase) + (voff)[_i]), (PG8_LAS unsigned*)(lds + (bufoff) + ldsw + _i * 8192), 16, 0, 0); } while (0)
#define PG8_LDA(dst, b, h) do { _Pragma("unroll") for (int m = 0; m < 4; ++m) _Pragma("unroll") for (int k = 0; k < 2; ++k) dst[m][k] = *(const PG8_LAS bf16x8*)(lds + PG8_SA(b, h) + aoff + m * 2048 + k * 1024); } while (0)
#define PG8_LDB(dst, b, h) do { _Pragma("unroll") for (int n = 0; n < 2; ++n) _Pragma("unroll") for (int k = 0; k < 2; ++k) dst[n][k] = *(const PG8_LAS bf16x8*)(lds + PG8_SB(b, h) + boff + n * 2048 + k * 1024); } while (0)
#define PG8_MMA(ai, bj, At, Bt) do { __builtin_amdgcn_s_setprio(1); _Pragma("unroll") for (int m = 0; m < 4; ++m) _Pragma("unroll") for (int n = 0; n < 2; ++n) _Pragma("unroll") for (int k = 0; k < 2; ++k) \
        acc[ai][bj][m][n] = __builtin_amdgcn_mfma_f32_16x16x32_bf16(Bt[n][k], At[m][k], acc[ai][bj][m][n], 0, 0, 0); __builtin_amdgcn_s_setprio(0); } while (0)
#define PG8_WAIT_V(n) asm volatile("s_waitcnt vmcnt(" #n ")" ::: "memory")
#define PG8_WAIT_L(n) asm volatile("s_waitcnt lgkmcnt(" #n ")" ::: "memory")
#define PG8_BAR __builtin_amdgcn_s_barrier()
#define PG8_SCHED __builtin_amdgcn_sched_barrier(0)
    Unit cur, nxt; int ui = 0;
    if (!S.next(0, cur)) return;
    f32x4 acc[2][2][4][2];
#pragma unroll
    for (int a = 0; a < 2; ++a)
#pragma unroll
        for (int b = 0; b < 2; ++b)
#pragma unroll
            for (int m = 0; m < 4; ++m)
#pragma unroll
                for (int n = 0; n < 2; ++n) acc[a][b][m][n] = (f32x4){0.f, 0.f, 0.f, 0.f};
    bf16x8 At[4][2], B0[2][2], B1[2][2];
    const char* cA = (const char*)g.A + (size_t)cur.pm * tstep + (size_t)cur.kq * g.ksub; const char* cB = (const char*)g.Bt + (size_t)cur.pn * tstep + (size_t)cur.kq * g.ksub;
    S.a_ready(cur);
    PG8_STAGE(PG8_SB(0, 0), cB, voffB); PG8_STAGE(PG8_SA(0, 0), cA, voffA); PG8_STAGE(PG8_SB(0, 1), cB + hstep, voffB); PG8_STAGE(PG8_SA(0, 1), cA + hstep, voffA);
    if (wr == 1) PG8_BAR;
    PG8_WAIT_V(4); PG8_BAR;
    PG8_STAGE(PG8_SB(1, 0), cB + kstep, voffB); PG8_STAGE(PG8_SA(1, 0), cA + kstep, voffA); PG8_STAGE(PG8_SB(1, 1), cB + hstep + kstep, voffB);
    PG8_WAIT_V(6); PG8_BAR;
    PG8_STAMP();
    for (;;) {
        const bool has_next = S.next(ui + 1, nxt);
        const char* nA = has_next ? (const char*)g.A + (size_t)nxt.pm * tstep + (size_t)nxt.kq * g.ksub : cA; const char* nB = has_next ? (const char*)g.Bt + (size_t)nxt.pn * tstep + (size_t)nxt.kq * g.ksub : cB;
        for (int t = 0; t < nt; t += 2) {
            const bool last = (t == nt - 2);
            const char* a1 = cA + (size_t)(t + 1) * kstep;
            const char* a2 = last ? nA : cA + (size_t)(t + 2) * kstep; const char* b2 = last ? nB : cB + (size_t)(t + 2) * kstep;
            const char* a3 = a2 + kstep; const char* b3 = b2 + kstep;
            if (last && has_next) S.a_ready(nxt);
            PG8_LDB(B0, 0, 0); PG8_SCHED; PG8_LDA(At, 0, 0); PG8_STAGE(PG8_SA(1, 1), a1 + hstep, voffA);
            PG8_WAIT_L(8); PG8_BAR; PG8_WAIT_L(0); PG8_MMA(0, 0, At, B0); PG8_BAR; PG8_SCHED;
            PG8_LDB(B1, 0, 1); PG8_STAGE(PG8_SB(0, 0), b2, voffB);
            PG8_BAR; PG8_WAIT_L(0); PG8_MMA(0, 1, At, B1); PG8_BAR;
            PG8_LDA(At, 0, 1); PG8_STAGE(PG8_SA(0, 0), a2, voffA);
            PG8_BAR; PG8_WAIT_L(0); PG8_MMA(1, 0, At, B0); PG8_BAR; PG8_SCHED;
            PG8_STAGE(PG8_SB(0, 1), b2 + hstep, voffB);
            PG8_WAIT_V(6); PG8_BAR; PG8_MMA(1, 1, At, B1); PG8_BAR;
            PG8_LDB(B0, 1, 0); PG8_SCHED; PG8_LDA(At, 1, 0); PG8_STAGE(PG8_SA(0, 1), a2 + hstep, voffA);
            PG8_WAIT_L(8); PG8_BAR; PG8_WAIT_L(0); PG8_MMA(0, 0, At, B0); PG8_BAR; PG8_SCHED;
            PG8_LDB(B1, 1, 1); PG8_STAGE(PG8_SB(1, 0), b3, voffB);
            PG8_BAR; PG8_WAIT_L(0); PG8_MMA(0, 1, At, B1); PG8_BAR;
            PG8_LDA(At, 1, 1); PG8_STAGE(PG8_SA(1, 0), a3, voffA);
            PG8_BAR; PG8_WAIT_L(0); PG8_MMA(1, 0, At, B0); PG8_BAR; PG8_SCHED;
            PG8_STAGE(PG8_SB(1, 1), b3 + hstep, voffB);
            PG8_WAIT_V(6); PG8_BAR; PG8_MMA(1, 1, At, B1); PG8_BAR;
        }
        PG8_STAMP();
        if constexpr (!Epi::AFTER_DRAIN) { E(acc, cur, wr, wc, fr, fq); S.done(cur); }
        PG8_STAMP();
        if (!has_next) break;
#pragma unroll
        for (int a = 0; a < 2; ++a)
#pragma unroll
            for (int b = 0; b < 2; ++b)
#pragma unroll
                for (int m = 0; m < 4; ++m)
#pragma unroll
                    for (int n = 0; n < 2; ++n) acc[a][b][m][n] = (f32x4){0.f, 0.f, 0.f, 0.f};
        cur = nxt; cA = nA; cB = nB; ++ui;
    }
    PG8_WAIT_V(0);
    if (wr == 0) PG8_BAR;
    PG8_BAR;
    if constexpr (Epi::AFTER_DRAIN) { E.fused(acc, cur, wr, wc, fr, fq, lds, wid, lane); S.done(cur); }
    PG8_STAMP();
    if (STAMP && wid == 0) { stamps[lane] = lane < nts ? (((unsigned long long)(unsigned)ts_hi << 32) | (unsigned)ts_lo) : 0ull;
        if (lane == 62) stamps[62] = rt_entry; if (lane == 63) stamps[63] = (unsigned long long)wall_clock64(); }
#undef PG8_STAMP
#undef PG8_SA
#undef PG8_SB
#undef PG8_STAGE
#undef PG8_LDA
#undef PG8_LDB
#undef PG8_MMA
#undef PG8_WAIT_V
#undef PG8_WAIT_L
#undef PG8_BAR
#undef PG8_SCHED
}
}
#define XB_TMO      128
#define XB_XCNT(j)  (256  + 64 * (j))
#define XB_XSUB(j)  (1280 + 64 * (j))
#define XB_XGEN(j)  (2304 + 64 * (j))
#define XB_TOP      3328
#define XB_TOPGEN   3392
#define XCD_BAR_WORDS 3456
#define XB_SPIN_CAP (1u << 18)
#define LAS __attribute__((address_space(3)))

__device__ __forceinline__ unsigned xb_ld(unsigned* p)              { return __hip_atomic_load(p, __ATOMIC_RELAXED, __HIP_MEMORY_SCOPE_AGENT); }
__device__ __forceinline__ unsigned xb_add(unsigned* p, unsigned v) { return __hip_atomic_fetch_add(p, v, __ATOMIC_RELAXED, __HIP_MEMORY_SCOPE_AGENT); }
__device__ __forceinline__ unsigned xb_xcc_id() { return (unsigned)__builtin_amdgcn_s_getreg((3 << 11) | 20) & 0xFu; }
#define XB_SPIN(cond, bar) do { unsigned _sp = 0; while (cond) { __builtin_amdgcn_s_sleep(1); \
    if ((++_sp & 255u) == 0u) { if (xb_ld(&(bar)[XB_TMO])) break; if (_sp > XB_SPIN_CAP) { atomicAdd(&(bar)[XB_TMO], 1u); break; } } } } while (0)

struct XcdBarrier {
    unsigned* bar; unsigned x;
    volatile LAS unsigned* st;
};

__device__ __forceinline__ XcdBarrier xcd_barrier_post(unsigned* bar, volatile LAS unsigned* st) {
    XcdBarrier b; b.bar = bar; b.x = xb_xcc_id(); b.st = st;
    if (threadIdx.x == 0) (void)xb_add(&bar[XB_XCNT(b.x)], 1u);
    return b;
}
__device__ __forceinline__ void xcd_barrier_complete(unsigned* bar, unsigned x, unsigned& nloc, unsigned& nx) {
    const unsigned G = gridDim.x * gridDim.y * gridDim.z;
    unsigned sum, cnt, mine, sp = 0u;
    for (;;) {
        sum = 0u; cnt = 0u; mine = 0u;
#pragma unroll
        for (unsigned j = 0; j < 16; ++j) { const unsigned c = xb_ld(&bar[XB_XCNT(j)]); sum += c; cnt += (c > 0u) ? 1u : 0u; mine = (j == x) ? c : mine; }
        if (sum == G) break;
        __builtin_amdgcn_s_sleep(1);
        if ((++sp & 255u) == 0u) { if (xb_ld(&bar[XB_TMO])) break; if (sp > XB_SPIN_CAP) { atomicAdd(&bar[XB_TMO], 1u); break; } }
    }
    nloc = mine > 0u ? mine : 1u; nx = cnt > 0u ? cnt : 1u;
}

__device__ __forceinline__ void xcd_barrier(const XcdBarrier& b) {
    asm volatile("s_waitcnt vmcnt(0)" ::: "memory");
    __syncthreads();
    if (threadIdx.x == 0) {
        unsigned* bar = b.bar;
        __builtin_amdgcn_s_waitcnt(0);
        unsigned nloc = b.st[0], nx = b.st[1];
        if (nloc == 0u) { xcd_barrier_complete(bar, b.x, nloc, nx); b.st[0] = nloc; b.st[1] = nx; }
        const unsigned old = xb_add(&bar[XB_XSUB(b.x)], 1u);
        const unsigned gen = old / nloc;
        if (old + 1u == (gen + 1u) * nloc) {
            __builtin_amdgcn_fence(__ATOMIC_RELEASE, "agent");
            asm volatile("s_waitcnt vmcnt(0)" ::: "memory");
            const unsigned og = xb_add(&bar[XB_TOP], 1u);
            const unsigned tg = og / nx;
            if (og + 1u == (tg + 1u) * nx) xb_add(&bar[XB_TOPGEN], 1u);
            else XB_SPIN(xb_ld(&bar[XB_TOPGEN]) == tg, bar);
            __builtin_amdgcn_fence(__ATOMIC_ACQUIRE, "agent");
            xb_add(&bar[XB_XGEN(b.x)], 1u);
            asm volatile("s_waitcnt vmcnt(0)" ::: "memory");
        } else {
            XB_SPIN(xb_ld(&bar[XB_XGEN(b.x)]) == gen, bar);
            __builtin_amdgcn_fence(__ATOMIC_ACQUIRE, "agent");
            asm volatile("s_waitcnt vmcnt(0)" ::: "memory");
        }
    }
    __syncthreads();
}


namespace cg = cooperative_groups;
namespace mk {
using pg8::bf16_t; using pg8::f32x4; using pg8::u32x4; using pg8::Unit;
typedef unsigned u32x2 __attribute__((ext_vector_type(2)));
typedef float f32x2 __attribute__((ext_vector_type(2)));
#define LDS_WAIT() asm volatile("s_waitcnt lgkmcnt(0)" ::: "memory")

constexpr int D = 2048, FF = 5632, ML = 16384, MC = 1024, MT = 17408, SEQ = 4096, CTXL = 256;
constexpr int NIN = 11520, NMOD = 18432;
constexpr int NITEM = 4352;

constexpr size_t al(size_t x) { return (x + 255) & ~(size_t)255; }
constexpr size_t OFF_MOD  = 0;
constexpr size_t OFF_H2   = al(OFF_MOD + (size_t)5 * NMOD * 4);
constexpr size_t OFF_HC   = al(OFF_H2 + (size_t)4096 * 64 * 4);
constexpr size_t OFF_ABF  = al(OFF_HC + (size_t)MC * D * 4);
constexpr size_t OFF_G    = al(OFF_ABF + (size_t)MT * 32 * 4);
constexpr size_t OFF_BETA = al(OFF_G + (size_t)MT * 16 * 4);
constexpr size_t OFF_XN   = al(OFF_BETA + (size_t)MT * 16 * 4);
constexpr size_t OFF_WA   = al(OFF_XN + (size_t)MT * D * 2);
constexpr size_t OFF_WA_D = OFF_WA + (size_t)2 * FF * D * 2;
constexpr size_t OFF_WB   = al(OFF_WA_D + (size_t)D * FF * 2);
constexpr size_t OFF_BIG  = al(OFF_WB + (size_t)NIN * D * 2);
constexpr size_t SZ_PH    = (size_t)ML * 3072 * 2;
constexpr size_t SZ_PQKV  = (size_t)MT * 3072 * 2;
constexpr size_t OFF_PH   = OFF_BIG;
constexpr size_t OFF_PQKV = OFF_BIG + SZ_PH;
constexpr size_t OFF_PB   = al(OFF_PQKV + SZ_PQKV);
constexpr size_t OFF_O    = al(OFF_PB + (size_t)ML * 5120 * 2);
constexpr size_t OFF_OG   = al(OFF_O + (size_t)2 * ML * 1024 * 2);
constexpr size_t OFF_BAR  = al(OFF_OG + (size_t)ML * 1024 * 2);
constexpr size_t WS_END   = al(OFF_BAR + (size_t)XCD_BAR_WORDS * 4);
constexpr size_t OFF_ACT  = OFF_BIG;
constexpr size_t OFF_U    = OFF_XN;
constexpr size_t OFF_W    = OFF_U + (size_t)NITEM * 64 * 128 * 2;
constexpr size_t OFF_QK   = OFF_W + (size_t)NITEM * 64 * 128 * 2;
constexpr size_t OFF_GC   = OFF_QK + (size_t)NITEM * 64 * 64 * 2;
constexpr size_t OFF_KFS  = OFF_XN;
constexpr size_t OFF_HYT  = OFF_PH;
constexpr size_t OFF_Z2   = OFF_PQKV + (size_t)ML * 1024 * 2;
constexpr size_t OFF_TMP  = OFF_BIG + (size_t)ML * 1024 * 2;
constexpr size_t OFF_Z2T  = OFF_PQKV;
constexpr size_t OFF_WHY  = OFF_WB;
constexpr size_t OFF_WGD  = OFF_WHY + (size_t)D * 1024 * 2;
constexpr size_t OFF_WO   = OFF_WGD + (size_t)D * 1024 * 2;
static_assert(OFF_GC + (size_t)NITEM * 128 * 4 <= OFF_BIG, "UWQK overflow");
static_assert(OFF_KFS + (size_t)2 * 1024 * 8192 * 8 <= OFF_WB, "KFS overflow");
static_assert((size_t)MT * FF * 2 <= OFF_PB - OFF_BIG, "ACT overflow");
static_assert(OFF_TMP + (size_t)ML * D * 4 <= OFF_PB, "TMP overflow");
static_assert(OFF_WO + (size_t)D * D * 2 <= OFF_BIG, "WB overflow");

constexpr int LDS_BYTES = 147456;

struct Args { const float* in[29]; float* out; unsigned char* ws; int ph_lo, ph_hi, sub, pad; };

__device__ __forceinline__ float wave_sum(float v) {
#pragma unroll
    for (int o = 1; o < 64; o <<= 1) v += __shfl_xor(v, o);
    return v;
}
__device__ __forceinline__ float bf2f(unsigned short b) { return __uint_as_float((unsigned)b << 16); }
__device__ __forceinline__ float bflo(unsigned w) { return __uint_as_float(w << 16); }
__device__ __forceinline__ float bfhi(unsigned w) { return __uint_as_float(w & 0xffff0000u); }
typedef __bf16 bf16x2_t __attribute__((ext_vector_type(2)));
__device__ __forceinline__ unsigned pk2(float lo, float hi) { return __builtin_bit_cast(unsigned, __builtin_convertvector((f32x2){lo, hi}, bf16x2_t)); }
__device__ __forceinline__ float silu_f(float x) { return x * __builtin_amdgcn_rcpf(1.f + __expf(-x)); }
__device__ __forceinline__ float sigm_f(float x) { return __builtin_amdgcn_rcpf(1.f + __expf(-x)); }

constexpr int CONV_SCR = 64 * 66 * 4;
__device__ __forceinline__ void conv_item(const float* __restrict__ W, int K, int Nsrc, bf16_t* __restrict__ WT, int kb, int n0dst, int n0src, int nvalid, float* scr, int lane) {
    const int k0 = 64 * kb, r4 = lane >> 4, c4 = (lane & 15) * 4;
    f32x4 v[16];
#pragma unroll
    for (int i = 0; i < 16; ++i) { v[i] = (f32x4){0.f, 0.f, 0.f, 0.f}; if (c4 < nvalid) v[i] = *(const f32x4*)(W + (size_t)(k0 + 4 * i + r4) * Nsrc + n0src + c4); }
#pragma unroll
    for (int i = 0; i < 16; ++i) { float* d = scr + (4 * i + r4) * 66 + c4; *(f32x2*)d = (f32x2){v[i].x, v[i].y}; *(f32x2*)(d + 2) = (f32x2){v[i].z, v[i].w}; }
    LDS_WAIT();
    const int c = lane & 7;
#pragma unroll
    for (int j = 0; j < 8; ++j) { const int n = (lane >> 3) + 8 * j; const float* s = scr + (8 * c) * 66 + n;
        u32x4 o; o.x = pk2(s[0], s[66]); o.y = pk2(s[132], s[198]); o.z = pk2(s[264], s[330]); o.w = pk2(s[396], s[462]);
        *(u32x4*)(WT + (size_t)(n0dst + n) * K + k0 + 8 * c) = o; }
    LDS_WAIT();
}
__device__ __forceinline__ int colmap(int mode, int n0, int& nvalid) {
    nvalid = 64;
    if (mode == 0) return n0;
    if (mode == 1) { const int pn = n0 >> 8, half = (n0 >> 7) & 1; return half * FF + pn * 128 + (n0 & 127); }
    if (n0 < 7168) return n0;
    if (n0 == 7168) { nvalid = 32; return 7168; }
    if (n0 < 7424) { nvalid = 0; return 0; }
    return 7200 + (n0 - 7424);
}
__device__ __forceinline__ void conv_matrix(const float* W, int K, int Nsrc, bf16_t* WT, int Ndst, int mode, int it, float* scr, int lane) {
    const int nblk = Ndst / 64, kb = it / nblk, nb = it % nblk; int nvalid;
    const int n0src = colmap(mode, nb * 64, nvalid);
    conv_item(W, K, Nsrc, WT, kb, nb * 64, n0src, nvalid, scr, lane);
}

__device__ __forceinline__ void norm_ada_row(const float* __restrict__ src, const float* __restrict__ gain, const float* __restrict__ shift, const float* __restrict__ scale, bf16_t* __restrict__ dst, int lane) {
    f32x4 v[8]; float ss = 0.f;
#pragma unroll
    for (int j = 0; j < 8; ++j) { v[j] = *(const f32x4*)(src + 4 * lane + 256 * j); ss += (v[j].x * v[j].x + v[j].y * v[j].y) + (v[j].z * v[j].z + v[j].w * v[j].w); }
    ss = wave_sum(ss);
    const float rstd = rsqrtf(ss * (1.f / 2048.f) + 1e-6f);
#pragma unroll
    for (int j = 0; j < 8; ++j) {
        const f32x4 g = *(const f32x4*)(gain + 4 * lane + 256 * j), sh = *(const f32x4*)(shift + 4 * lane + 256 * j), sc = *(const f32x4*)(scale + 4 * lane + 256 * j);
        const f32x4 y = (v[j] * rstd) * g; const f32x4 o = y * (sc + 1.f) + sh;
        u32x2 w; w.x = pk2(o.x, o.y); w.y = pk2(o.z, o.w);
        *(u32x2*)(dst + 4 * lane + 256 * j) = w; }
}
__device__ __forceinline__ void norm_ada_row_ctx(const float* __restrict__ src, const float* __restrict__ part, const float* __restrict__ gain, const float* __restrict__ shift, const float* __restrict__ scale, bf16_t* __restrict__ dst, int lane) {
    f32x4 v[8]; float ss = 0.f;
#pragma unroll
    for (int j = 0; j < 8; ++j) { const int o = 4 * lane + 256 * j;
        v[j] = *(const f32x4*)(src + o) + ((*(const f32x4*)(part + o) + *(const f32x4*)(part + (size_t)MC * D + o)) + (*(const f32x4*)(part + (size_t)2 * MC * D + o) + *(const f32x4*)(part + (size_t)3 * MC * D + o)));
        ss += (v[j].x * v[j].x + v[j].y * v[j].y) + (v[j].z * v[j].z + v[j].w * v[j].w); }
    ss = wave_sum(ss);
    const float rstd = rsqrtf(ss * (1.f / 2048.f) + 1e-6f);
#pragma unroll
    for (int j = 0; j < 8; ++j) {
        const f32x4 g = *(const f32x4*)(gain + 4 * lane + 256 * j), sh = *(const f32x4*)(shift + 4 * lane + 256 * j), sc = *(const f32x4*)(scale + 4 * lane + 256 * j);
        const f32x4 y = (v[j] * rstd) * g; const f32x4 o = y * (sc + 1.f) + sh;
        u32x2 w; w.x = pk2(o.x, o.y); w.y = pk2(o.z, o.w);
        *(u32x2*)(dst + 4 * lane + 256 * j) = w; }
}
__device__ __forceinline__ void final_norm_row(float* __restrict__ row, const float* __restrict__ gain, int lane) {
    f32x4 v[8]; float ss = 0.f;
#pragma unroll
    for (int j = 0; j < 8; ++j) { v[j] = *(const f32x4*)(row + 4 * lane + 256 * j); ss += (v[j].x * v[j].x + v[j].y * v[j].y) + (v[j].z * v[j].z + v[j].w * v[j].w); }
    ss = wave_sum(ss);
    const float rstd = rsqrtf(ss * (1.f / 2048.f) + 1e-6f);
#pragma unroll
    for (int j = 0; j < 8; ++j) { const f32x4 g = *(const f32x4*)(gain + 4 * lane + 256 * j); *(f32x4*)(row + 4 * lane + 256 * j) = (v[j] * rstd) * g; }
}

struct EpiSwiglu {
    static constexpr bool PERM = true, AFTER_DRAIN = false;
    bf16_t* O; int ldc;
    __device__ __forceinline__ void operator()(const f32x4 (&acc)[2][2][4][2], const Unit& u, int wr, int wc, int fr, int fq) const {
        const int row0 = u.pm * 256 + wr * 64 + fr, col0 = u.pn * 128 + wc * 32 + 8 * fq;
#pragma unroll
        for (int ai = 0; ai < 2; ++ai)
#pragma unroll
            for (int m = 0; m < 4; ++m) {
                const f32x4 g0 = acc[ai][0][m][0], g1 = acc[ai][0][m][1], u0 = acc[ai][1][m][0], u1 = acc[ai][1][m][1];
                u32x4 w;
                w.x = pk2(silu_f(g0[0]) * u0[0], silu_f(g0[1]) * u0[1]); w.y = pk2(silu_f(g0[2]) * u0[2], silu_f(g0[3]) * u0[3]);
                w.z = pk2(silu_f(g1[0]) * u1[0], silu_f(g1[1]) * u1[1]); w.w = pk2(silu_f(g1[2]) * u1[2], silu_f(g1[3]) * u1[3]);
                *(u32x4*)(O + (size_t)(row0 + ai * 128 + m * 16) * ldc + col0) = w; }
    }
};
struct EpiResid {
    static constexpr bool PERM = false, AFTER_DRAIN = false;
    const float* inL; const float* inC; float* outL; float* outC; const float* gate0; float s;
    __device__ __forceinline__ void operator()(const f32x4 (&acc)[2][2][4][2], const Unit& u, int wr, int wc, int fr, int fq) const {
        const bool lat = u.pm < 64; const int bm = lat ? (u.pm >> 4) : 4; const int rb = lat ? u.pm * 256 : (u.pm - 64) * 256;
        const float* in = lat ? inL : inC; float* out = lat ? outL : outC; const float* gate = gate0 + (size_t)bm * NMOD;
        const int row0 = rb + wr * 64 + fr, col0 = u.pn * 256 + wc * 32 + 4 * fq;
        f32x4 gv[2][2];
#pragma unroll
        for (int bj = 0; bj < 2; ++bj)
#pragma unroll
            for (int n = 0; n < 2; ++n) gv[bj][n] = *(const f32x4*)(gate + col0 + bj * 128 + n * 16) * s;
#pragma unroll
        for (int ai = 0; ai < 2; ++ai)
#pragma unroll
            for (int m = 0; m < 4; ++m) { const size_t off = (size_t)(row0 + ai * 128 + m * 16) * D + col0;
#pragma unroll
                for (int bj = 0; bj < 2; ++bj)
#pragma unroll
                    for (int n = 0; n < 2; ++n) { const f32x4 x = *(const f32x4*)(in + off + bj * 128 + n * 16); *(f32x4*)(out + off + bj * 128 + n * 16) = x + gv[bj][n] * acc[ai][bj][m][n]; } }
    }
};
struct EpiWin {
    static constexpr bool PERM = true, AFTER_DRAIN = false;
    bf16_t* PH; bf16_t* PQKV; bf16_t* PB; float* ABF;
    __device__ __forceinline__ void operator()(const f32x4 (&acc)[2][2][4][2], const Unit& u, int wr, int wc, int fr, int fq) const {
        const int row0 = u.pm * 256 + wr * 64 + fr, cin = wc * 32 + 8 * fq; const int pn = u.pn;
        if (pn == 28) {
            if (wc == 0) {
#pragma unroll
                for (int ai = 0; ai < 2; ++ai)
#pragma unroll
                    for (int m = 0; m < 4; ++m) { float* p = ABF + (size_t)(row0 + ai * 128 + m * 16) * 32 + 8 * fq; *(f32x4*)p = acc[ai][0][m][0]; *(f32x4*)(p + 4) = acc[ai][0][m][1]; } }
            return; }
        if (pn < 12) {
#pragma unroll
            for (int ai = 0; ai < 2; ++ai)
#pragma unroll
                for (int m = 0; m < 4; ++m) { const int r = row0 + ai * 128 + m * 16; const size_t bt = (size_t)(r >> 12) * 4096 + (r & 4095);
#pragma unroll
                    for (int bj = 0; bj < 2; ++bj) { const f32x4 v0 = acc[ai][bj][m][0], v1 = acc[ai][bj][m][1];
                        const unsigned p0 = pk2(v0[0], v0[1]), p1 = pk2(v0[2], v0[3]), p2 = pk2(v1[0], v1[1]), p3 = pk2(v1[2], v1[3]);
                        bf16_t* cp = PH + (size_t)(256 * pn + bj * 128 + cin) * 16384 + bt;
                        cp[0 * 16384] = (bf16_t)(p0 & 0xffffu); cp[1 * 16384] = (bf16_t)(p0 >> 16); cp[2 * 16384] = (bf16_t)(p1 & 0xffffu); cp[3 * 16384] = (bf16_t)(p1 >> 16);
                        cp[4 * 16384] = (bf16_t)(p2 & 0xffffu); cp[5 * 16384] = (bf16_t)(p2 >> 16); cp[6 * 16384] = (bf16_t)(p3 & 0xffffu); cp[7 * 16384] = (bf16_t)(p3 >> 16); } }
            return; }
        bf16_t* base; int ldc; bool sg = false;
        if (pn < 24) { base = PQKV + 256 * (pn - 12); ldc = 3072; }
        else if (pn < 28) { base = PB + 256 * (pn - 24); ldc = 5120; }
        else { base = PB + 1024 + 256 * (pn - 29); ldc = 5120; sg = true; }
#pragma unroll
        for (int ai = 0; ai < 2; ++ai)
#pragma unroll
            for (int m = 0; m < 4; ++m) { bf16_t* rowp = base + (size_t)(row0 + ai * 128 + m * 16) * ldc + cin;
#pragma unroll
                for (int bj = 0; bj < 2; ++bj) { f32x4 v0 = acc[ai][bj][m][0], v1 = acc[ai][bj][m][1];
                    if (sg) {
#pragma unroll
                        for (int j = 0; j < 4; ++j) { v0[j] = sigm_f(v0[j]); v1[j] = sigm_f(v1[j]); } }
                    u32x4 w; w.x = pk2(v0[0], v0[1]); w.y = pk2(v0[2], v0[3]); w.z = pk2(v1[0], v1[1]); w.w = pk2(v1[2], v1[3]);
                    *(u32x4*)(rowp + bj * 128) = w; } }
    }
};
template <int SECOND> struct EpiMerge {
    static constexpr bool PERM = false, AFTER_DRAIN = false;
    const bf16_t* gates; float* TMP; bf16_t* OUT;
    __device__ __forceinline__ void operator()(const f32x4 (&acc)[2][2][4][2], const Unit& u, int wr, int wc, int fr, int fq) const {
        const int row0 = u.pm * 256 + wr * 64 + fr, col0 = u.pn * 256 + wc * 32 + 4 * fq;
#pragma unroll
        for (int ai = 0; ai < 2; ++ai)
#pragma unroll
            for (int m = 0; m < 4; ++m) { const size_t r = (size_t)(row0 + ai * 128 + m * 16);
#pragma unroll
                for (int bj = 0; bj < 2; ++bj)
#pragma unroll
                    for (int n = 0; n < 2; ++n) { const int c = col0 + bj * 128 + n * 16;
                        const u32x2 gw = *(const u32x2*)(gates + r * 5120 + c);
                        const f32x4 g = (f32x4){bflo(gw.x), bfhi(gw.x), bflo(gw.y), bfhi(gw.y)};
                        if (SECOND == 0) { const f32x4 t = g * acc[ai][bj][m][n]; u32x2 w; w.x = pk2(t.x, t.y); w.y = pk2(t.z, t.w); *(u32x2*)((bf16_t*)TMP + r * D + c) = w; }
                        else { const u32x2 pw = *(const u32x2*)((const bf16_t*)TMP + r * D + c);
                            const f32x4 t = (f32x4){bflo(pw.x), bfhi(pw.x), bflo(pw.y), bfhi(pw.y)} + g * acc[ai][bj][m][n]; u32x2 w; w.x = pk2(t.x, t.y); w.y = pk2(t.z, t.w); *(u32x2*)(OUT + r * D + c) = w; } } }
    }
};
struct CtxSplitOrder {
    int G, c;
    __device__ bool next(int i, Unit& u) const { const long L = (long)i * G + c; if (L >= 128) return false;
        u.kq = (int)(L & 3); u.pn = (int)((L >> 2) & 7); u.pm = (int)(L >> 5); return true; }
    __device__ __forceinline__ void a_ready(const Unit&) const {}
    __device__ __forceinline__ void done(const Unit&) const {}
};
struct EpiCtxPart {
    static constexpr bool PERM = false, AFTER_DRAIN = false;
    float* P; const float* gate; float s;
    __device__ __forceinline__ void operator()(const f32x4 (&acc)[2][2][4][2], const Unit& u, int wr, int wc, int fr, int fq) const {
        const int row0 = u.pm * 256 + wr * 64 + fr, col0 = u.pn * 256 + wc * 32 + 4 * fq; float* out = P + (size_t)u.kq * MC * D;
        f32x4 gv[2][2];
#pragma unroll
        for (int bj = 0; bj < 2; ++bj)
#pragma unroll
            for (int n = 0; n < 2; ++n) gv[bj][n] = *(const f32x4*)(gate + col0 + bj * 128 + n * 16) * s;
#pragma unroll
        for (int ai = 0; ai < 2; ++ai)
#pragma unroll
            for (int m = 0; m < 4; ++m) { const size_t off = (size_t)(row0 + ai * 128 + m * 16) * D + col0;
#pragma unroll
                for (int bj = 0; bj < 2; ++bj)
#pragma unroll
                    for (int n = 0; n < 2; ++n) *(f32x4*)(out + off + bj * 128 + n * 16) = gv[bj][n] * acc[ai][bj][m][n]; }
    }
};
struct WinOrder : pg8::StaticOrder {
    __device__ bool next(int i, Unit& u) const {
        if (pg8::StaticOrder::next(i, u)) return true;
        const long L = (long)i * G + c - nwg; if (L >= 52) return false;
        const int q = (int)(L % 13); u.pm = 64 + (int)(L / 13); u.pn = q < 12 ? 12 + q : 28; u.kq = 0; return true;
    }
};

__device__ __forceinline__ void phase_mod(const float* c, const float* c_ctx, const float* w_mod, const float* b_mod, float* MOD, unsigned char* smem, int tid) {
    float* sS = (float*)smem;
    float* sR = (float*)(smem + 40960);
    const int lane = tid & 63, wv = tid >> 6;
    for (int wg = blockIdx.x; wg < 144; wg += gridDim.x) {
        const int col0 = wg * 128;
        for (int idx = tid; idx < 5 * 2048; idx += 512) { const int r = idx >> 11, k = idx & 2047; const float cv = r < 4 ? c[r * 2048 + k] : c_ctx[k]; sS[idx] = cv / (1.f + expf(-cv)); }
        __syncthreads();
        float a0[5], a1[5];
#pragma unroll
        for (int r = 0; r < 5; ++r) { a0[r] = 0.f; a1[r] = 0.f; }
        const int kb = wv * 256;
#pragma unroll 8
        for (int k = kb; k < kb + 256; ++k) {
            const f32x2 w = *(const f32x2*)(w_mod + (size_t)k * NMOD + col0 + 2 * lane);
#pragma unroll
            for (int r = 0; r < 5; ++r) { const float s = sS[r * 2048 + k]; a0[r] += s * w.x; a1[r] += s * w.y; } }
#pragma unroll
        for (int r = 0; r < 5; ++r) { sR[(wv * 5 + r) * 128 + 2 * lane] = a0[r]; sR[(wv * 5 + r) * 128 + 2 * lane + 1] = a1[r]; }
        __syncthreads();
        for (int idx = tid; idx < 5 * 128; idx += 512) { const int r = idx >> 7, cc = idx & 127; float s = 0.f;
#pragma unroll
            for (int w = 0; w < 8; ++w) s += sR[(w * 5 + r) * 128 + cc];
            MOD[(size_t)r * NMOD + col0 + cc] = s + b_mod[col0 + cc]; }
        __syncthreads();
    }
}
__device__ __forceinline__ void phase_h2(const float* w1, const float* b1, const float* w2, const float* b2, const float* freq, float* H2, int gw, int ngw, int lane) {
    for (int t = gw; t < 4096; t += ngw) {
        const float tt = (float)t * (1.f / 4096.f);
        float zf = 0.f;
        if (lane == 0) zf = tt;
        else if (lane <= 16) { const float f = 1e-4f + (float)(lane - 1) * ((15.f - 1e-4f) / 15.f); zf = cosf((6.283185307179586f * tt) * f); }
        else if (lane <= 32) { const float f = 1e-4f + (float)(lane - 17) * ((15.f - 1e-4f) / 15.f); zf = -sinf((6.283185307179586f * tt) * f); }
        float a = 0.f;
        for (int e = 0; e < 33; ++e) a += __shfl(zf, e) * w1[e * 64 + lane];
        const float fr = freq[lane];
        const float h1 = sinf(fr * (a + b1[lane]));
        float a2 = 0.f;
        for (int j = 0; j < 64; ++j) a2 += __shfl(h1, j) * w2[j * 64 + lane];
        H2[t * 64 + lane] = sinf(fr * (a2 + b2[lane]));
    }
}

__device__ __forceinline__ void gdn_conv_rows(bf16_t* PQKV, const unsigned short* sRaw, int r0, int T, int hc, int cc, float w00, float w01, float w10, float w11, float w20, float w21, int lane, int wv) {
    for (int i = wv; i < T; i += 8) {
        const unsigned x0 = *(const unsigned*)(sRaw + i * 128 + 2 * lane);
        const unsigned xm = i > 0 ? *(const unsigned*)(sRaw + (i - 1) * 128 + 2 * lane) : 0u;
        const unsigned xp = i < T - 1 ? *(const unsigned*)(sRaw + (i + 1) * 128 + 2 * lane) : 0u;
        float y0 = w00 * bflo(xm) + w10 * bflo(x0) + w20 * bflo(xp);
        float y1 = w01 * bfhi(xm) + w11 * bfhi(x0) + w21 * bfhi(xp);
        y0 = silu_f(y0); y1 = silu_f(y1);
        if (hc < 16) { const float ss = wave_sum(y0 * y0 + y1 * y1); float sc = rsqrtf(ss + 1e-6f); if (hc < 8) sc *= 0.08838834764831845f; y0 *= sc; y1 *= sc; }
        *(unsigned*)(PQKV + (size_t)(r0 + i) * 3072 + cc) = pk2(y0, y1);
    }
}
__device__ __forceinline__ void phase_gdn_conv(bf16_t* PQKV, const float* conv_w, unsigned char* smem, int tid) {
    unsigned short* sRaw = (unsigned short*)smem;
    const int lane = tid & 63, wv = tid >> 6;
    {
        const int rowa = tid >> 4, part = tid & 15;
        u32x4 xa = (u32x4){0u, 0u, 0u, 0u}, xb = xa; float n00 = 0.f, n01 = 0.f, n10 = 0.f, n11 = 0.f, n20 = 0.f, n21 = 0.f;
#define GC_LOAD(it_) do { const int seg_ = (it_) / 24, hc_ = (it_) % 24; const bf16_t* p_ = PQKV + (size_t)(seg_ * 64 + rowa) * 3072 + hc_ * 128 + part * 8; \
            xa = *(const u32x4*)p_; xb = *(const u32x4*)(p_ + (size_t)32 * 3072); const int cc_ = hc_ * 128 + 2 * lane; \
            n00 = conv_w[cc_]; n01 = conv_w[cc_ + 1]; n10 = conv_w[3072 + cc_]; n11 = conv_w[3072 + cc_ + 1]; n20 = conv_w[6144 + cc_]; n21 = conv_w[6144 + cc_ + 1]; } while (0)
        int item = blockIdx.x;
        if (item < 6144) GC_LOAD(item);
        for (; item < 6144; item += gridDim.x) {
            const int seg = item / 24, hc = item % 24;
            const u32x4 ca = xa, cb = xb; const float w00 = n00, w01 = n01, w10 = n10, w11 = n11, w20 = n20, w21 = n21;
            *(u32x4*)(sRaw + rowa * 128 + part * 8) = ca; *(u32x4*)(sRaw + (rowa + 32) * 128 + part * 8) = cb;
            __syncthreads();
            if (item + (int)gridDim.x < 6144) GC_LOAD(item + (int)gridDim.x);
            gdn_conv_rows(PQKV, sRaw, seg * 64, 64, hc, hc * 128 + 2 * lane, w00, w01, w10, w11, w20, w21, lane, wv);
            __syncthreads();
        }
#undef GC_LOAD
    }
    for (int item = 6144 + blockIdx.x; item < 6144 + 64; item += gridDim.x) {
        const int q = item - 6144, hc = 8 + (q & 15), r0 = ML + (q >> 4) * 256, T = 256;
        const int col0 = hc * 128;
        for (int ch = tid; ch < T * 16; ch += 512) { const int row = ch >> 4, part = ch & 15;
            *(u32x4*)(sRaw + row * 128 + part * 8) = *(const u32x4*)(PQKV + (size_t)(r0 + row) * 3072 + col0 + part * 8); }
        const int cc = col0 + 2 * lane;
        const float w00 = conv_w[cc], w01 = conv_w[cc + 1], w10 = conv_w[3072 + cc], w11 = conv_w[3072 + cc + 1], w20 = conv_w[6144 + cc], w21 = conv_w[6144 + cc + 1];
        __syncthreads();
        gdn_conv_rows(PQKV, sRaw, r0, T, hc, cc, w00, w01, w10, w11, w20, w21, lane, wv);
        __syncthreads();
    }
}
__device__ __forceinline__ void phase_gbeta(const float* ABF, const float* a_log, const float* dt_bias, float* G, float* BETA, int gtid, int ngt) {
    for (int idx = gtid; idx < MT * 16; idx += ngt) { const int r = idx >> 4, e = idx & 15;
        const float a = ABF[(size_t)r * 32 + e] + dt_bias[e], bb = ABF[(size_t)r * 32 + 16 + e];
        const float sp = a > 20.f ? a : log1pf(expf(a));
        G[idx] = -expf(a_log[e]) * sp; BETA[idx] = 1.f / (1.f + expf(-bb)); }
}

__device__ __forceinline__ int chunk_row(int item, int i, int& h, int& dir) {
    int n, b, Ls, rb;
    if (item < 4096) { n = item & 63; h = (item >> 6) & 7; b = (item >> 9) & 3; dir = item >> 11; Ls = SEQ; rb = b * SEQ; }
    else { const int q = item - 4096; n = q & 3; h = (q >> 2) & 7; b = (q >> 5) & 3; dir = q >> 7; Ls = CTXL; rb = ML + b * CTXL; }
    const int p = n * 64 + i;
    return rb + (dir ? Ls - 1 - p : p);
}
__device__ __forceinline__ unsigned pk2_rne(float lo, float hi) { return pk2(lo, hi); }
#define PREP_MFMA(a_, b_, c_) __builtin_amdgcn_mfma_f32_16x16x32_bf16(__builtin_bit_cast(pg8::bf16x8, (a_)), __builtin_bit_cast(pg8::bf16x8, (b_)), (c_), 0, 0, 0)
__device__ __forceinline__ void phase_gdn_prep(const bf16_t* PQKV, const float* G, const float* BETA, bf16_t* U, bf16_t* W, bf16_t* QK, float* GC, unsigned char* smem, int tid) {
    const int lane = tid & 63, wv = tid >> 6, fr = lane & 15, fq = lane >> 4;
    float* sT = (float*)(smem + wv * 18176);
    float* sGc = sT + 64 * 68;
    float* sBe = sGc + 64;
    float* sBg = sBe + 64;
    for (int item = blockIdx.x * 8 + wv; item < NITEM; item += gridDim.x * 8) {
        int n, h, b, dir, Ls, rb;
        if (item < 4096) { n = item & 63; h = (item >> 6) & 7; b = (item >> 9) & 3; dir = item >> 11; Ls = SEQ; rb = b * SEQ; }
        else { const int q = item - 4096; n = q & 3; h = (q >> 2) & 7; b = (q >> 5) & 3; dir = q >> 7; Ls = CTXL; rb = ML + b * CTXL; }
        const int r0 = rb + (dir ? Ls - 1 - n * 64 : n * 64), sg = dir ? -1 : 1;
        {
            const int row = r0 + sg * lane;
            float g = G[(size_t)row * 16 + dir * 8 + h]; const float be = BETA[(size_t)row * 16 + dir * 8 + h];
#pragma unroll
            for (int o = 1; o < 64; o <<= 1) { const float t = __shfl_up(g, o); if (lane >= o) g += t; }
            sGc[lane] = g; sBe[lane] = be; sBg[lane] = be * expf(g);
            const float gl = __shfl(g, 63);
            GC[(size_t)item * 128 + lane] = expf(g); GC[(size_t)item * 128 + 64 + lane] = expf(gl - g);
        }
        LDS_WAIT();
        const bf16_t* base = PQKV + h * 128 + fq * 8;
        {
            u32x4 kf[4][4];
#pragma unroll
            for (int t4 = 0; t4 < 4; ++t4) { const bf16_t* ip = base + (size_t)(r0 + sg * (t4 * 16 + fr)) * 3072;
#pragma unroll
                for (int kc = 0; kc < 4; ++kc) kf[t4][kc] = *(const u32x4*)(ip + 1024 + kc * 32); }
#pragma unroll
            for (int ti = 0; ti < 4; ++ti) {
                const int i = ti * 16 + fr; const float gi = sGc[i], bi = sBe[i];
                u32x4 qx[4];
                { const bf16_t* ip = base + (size_t)(r0 + sg * i) * 3072;
#pragma unroll
                  for (int kc = 0; kc < 4; ++kc) qx[kc] = *(const u32x4*)(ip + kc * 32); }
#pragma unroll
                for (int tj = 0; tj < 4; ++tj) {
                    f32x4 aa = (f32x4){0.f, 0.f, 0.f, 0.f}, aq = (f32x4){0.f, 0.f, 0.f, 0.f};
                    if (tj <= ti) {
#pragma unroll
                        for (int kc = 0; kc < 4; ++kc) { aa = PREP_MFMA(kf[tj][kc], kf[ti][kc], aa); aq = PREP_MFMA(kf[tj][kc], qx[kc], aq); }
                    }
                    const int j0 = tj * 16 + fq * 4; const f32x4 gj = *(const f32x4*)(sGc + j0);
                    float av[4], qv[4];
#pragma unroll
                    for (int jj = 0; jj < 4; ++jj) { const int j = j0 + jj; const float dec = i >= j ? __expf(gi - gj[jj]) : 0.f;
                        av[jj] = i > j ? bi * aa[jj] * dec : 0.f; qv[jj] = aq[jj] * dec; }
                    if (tj <= ti) *(f32x4*)(sT + i * 68 + j0) = (f32x4){av[0], av[1], av[2], av[3]};
                    u32x2 p; p.x = pk2_rne(qv[0], qv[1]); p.y = pk2_rne(qv[2], qv[3]);
                    *(u32x2*)(QK + ((size_t)item * 64 + i) * 64 + j0) = p;
                }
            }
        }
        LDS_WAIT();
        {
            float t[64]; const float lanef = (float)lane;
#pragma unroll
            for (int i = 0; i < 64; ++i) {
                float a = fmaxf(0.f, 1.f - fabsf(lanef - (float)i));
#pragma unroll
                for (int j0 = 0; j0 < i; j0 += 4) { const f32x4 ar = *(const f32x4*)(sT + i * 68 + j0);
                    a -= ar.x * t[j0];
                    if (j0 + 1 < i) a -= ar.y * t[j0 + 1];
                    if (j0 + 2 < i) a -= ar.z * t[j0 + 2];
                    if (j0 + 3 < i) a -= ar.w * t[j0 + 3]; }
                t[i] = a;
            }
            LDS_WAIT();
#pragma unroll
            for (int i = 0; i < 64; ++i) sT[i * 68 + lane] = t[i];
        }
        LDS_WAIT();
#define PREP_X(X_, SC_) do { \
            _Pragma("unroll") for (int ti_ = 0; ti_ < 4; ++ti_) _Pragma("unroll") for (int kc_ = 0; kc_ < 2; ++kc_) { \
                if (kc_ * 32 > ti_ * 16 + 15) { X_[ti_][kc_] = (u32x4){0u, 0u, 0u, 0u}; continue; } \
                const int jb_ = kc_ * 32 + fq * 8; const float* tp_ = sT + (ti_ * 16 + fr) * 68 + jb_; \
                const f32x4 t0_ = *(const f32x4*)tp_, t1_ = *(const f32x4*)(tp_ + 4); \
                const f32x4 s0_ = *(const f32x4*)((SC_) + jb_), s1_ = *(const f32x4*)((SC_) + jb_ + 4); \
                const f32x4 u0_ = t0_ * s0_, u1_ = t1_ * s1_; \
                X_[ti_][kc_] = (u32x4){pk2(u0_.x, u0_.y), pk2(u0_.z, u0_.w), pk2(u1_.x, u1_.y), pk2(u1_.z, u1_.w)}; } } while (0)
        const bf16_t* vcol = PQKV + h * 128 + fr;
#define PREP_UW(COFF_, X_, DST_) do { u32x4 y_[4][2]; \
            _Pragma("unroll") for (int tl_ = 0; tl_ < 4; ++tl_) _Pragma("unroll") for (int kc_ = 0; kc_ < 2; ++kc_) { unsigned e_[8]; \
                _Pragma("unroll") for (int q_ = 0; q_ < 8; ++q_) e_[q_] = vcol[(size_t)(r0 + sg * (kc_ * 32 + fq * 8 + q_)) * 3072 + (COFF_) + (td0 + tl_) * 16]; \
                y_[tl_][kc_] = (u32x4){e_[0] | (e_[1] << 16), e_[2] | (e_[3] << 16), e_[4] | (e_[5] << 16), e_[6] | (e_[7] << 16)}; } \
            _Pragma("unroll") for (int tl_ = 0; tl_ < 4; ++tl_) _Pragma("unroll") for (int ti_ = 0; ti_ < 4; ++ti_) { \
                f32x4 a_ = (f32x4){0.f, 0.f, 0.f, 0.f}; a_ = PREP_MFMA(y_[tl_][0], X_[ti_][0], a_); if (ti_ >= 2) a_ = PREP_MFMA(y_[tl_][1], X_[ti_][1], a_); \
                u32x2 p_; p_.x = pk2_rne(a_[0], a_[1]); p_.y = pk2_rne(a_[2], a_[3]); \
                *(u32x2*)((DST_) + ((size_t)item * 64 + ti_ * 16 + fr) * 128 + (td0 + tl_) * 16 + fq * 4) = p_; } \
            asm volatile("" ::: "memory"); } while (0)
        {   u32x4 xx[4][2];
            PREP_X(xx, sBe);
#pragma unroll 1
            for (int td0 = 0; td0 < 8; td0 += 4) PREP_UW(2048, xx, U);
            PREP_X(xx, sBg);
#pragma unroll 1
            for (int td0 = 0; td0 < 8; td0 += 4) PREP_UW(1024, xx, W);
        }
#undef PREP_UW
#undef PREP_X
        LDS_WAIT();
    }
}

__device__ __forceinline__ unsigned f2bf_bits(float f) { return pk2(f, 0.f) & 0xffffu; }
__device__ __forceinline__ unsigned pk2s(float lo, float hi) { return pk2(lo, hi); }
#define MK_MFMA(a_, b_, c_) __builtin_amdgcn_mfma_f32_16x16x32_bf16(__builtin_bit_cast(pg8::bf16x8, (a_)), __builtin_bit_cast(pg8::bf16x8, (b_)), (c_), 0, 0, 0)
__device__ __forceinline__ void phase_scan(const bf16_t* PQKV, const bf16_t* U, const bf16_t* W, const bf16_t* QK, const float* GC, bf16_t* O, unsigned char* smem, int tid, int vb) {
    unsigned short* sSt = (unsigned short*)smem;
    unsigned short* sVt = sSt + 32 * 136;
    unsigned short* sVd = sVt + 32 * 72;
    unsigned short* sKt = sVd + 32 * 72;
    float* sE = (float*)(sKt + 2 * 128 * 72);
    const int lane = tid & 63, w = tid >> 6, fr = lane & 15, fq = lane >> 4, ti = w >> 1, te = w & 1;
    for (int wg = vb; wg < 256; wg += gridDim.x) {
        const int dir = wg >> 7, b = (wg >> 5) & 3, h = (wg >> 2) & 7, sl = wg & 3;
        const int dbh = (dir * 4 + b) * 8 + h;
        __syncthreads();
        for (int idx = tid; idx < 32 * 136; idx += 512) sSt[idx] = 0;
        f32x4 S0 = (f32x4){0.f, 0.f, 0.f, 0.f}, S1 = (f32x4){0.f, 0.f, 0.f, 0.f};
        u32x4 wf[4], qf[4], qkf[2], kr[2]; unsigned short ur[4]; float gcr = 0.f;
#pragma unroll
        for (int k = 0; k < 4; ++k) qf[k] = (u32x4){0u, 0u, 0u, 0u};
        qkf[0] = qkf[1] = (u32x4){0u, 0u, 0u, 0u};
#define SCAN_LOAD(step_) do { const int st_ = (step_); const bool lat_ = st_ >= 4; const int item_ = lat_ ? dbh * 64 + (st_ - 4) : 4096 + dbh * 4 + st_; \
            const int n_ = lat_ ? st_ - 4 : st_; const int Ls_ = lat_ ? SEQ : CTXL; const int rb_ = lat_ ? b * SEQ : ML + b * CTXL; \
            { const bf16_t* wp_ = W + (size_t)item_ * 8192 + (ti * 16 + fr) * 128 + fq * 8; \
              _Pragma("unroll") for (int kc_ = 0; kc_ < 4; ++kc_) wf[kc_] = *(const u32x4*)(wp_ + kc_ * 32); } \
            if (lat_) { const int p_ = n_ * 64 + ti * 16 + fr; const int row_ = rb_ + (dir ? Ls_ - 1 - p_ : p_); \
              const bf16_t* qp_ = PQKV + (size_t)row_ * 3072 + h * 128 + fq * 8; \
              _Pragma("unroll") for (int kc_ = 0; kc_ < 4; ++kc_) qf[kc_] = *(const u32x4*)(qp_ + kc_ * 32); \
              const bf16_t* qkp_ = QK + (size_t)item_ * 4096 + (ti * 16 + fr) * 64 + fq * 8; qkf[0] = *(const u32x4*)qkp_; qkf[1] = *(const u32x4*)(qkp_ + 32); } \
            { const int p_ = n_ * 64 + lane; const int row_ = rb_ + (dir ? Ls_ - 1 - p_ : p_); \
              const bf16_t* kp_ = PQKV + (size_t)row_ * 3072 + 1024 + h * 128 + w * 16; kr[0] = *(const u32x4*)kp_; kr[1] = *(const u32x4*)(kp_ + 8); } \
            _Pragma("unroll") for (int j_ = 0; j_ < 4; ++j_) ur[j_] = U[((size_t)item_ * 64 + ti * 16 + fq * 4 + j_) * 128 + sl * 32 + te * 16 + fr]; \
            if (tid < 128) gcr = GC[(size_t)item_ * 128 + tid]; } while (0)
#define SCAN_STAGE(buf_) do { unsigned short* kb_ = sKt + (buf_) * (128 * 72); \
            _Pragma("unroll") for (int hh_ = 0; hh_ < 2; ++hh_) { const u32x4 k_ = kr[hh_]; unsigned short* d_ = kb_ + (w * 16 + hh_ * 8) * 72 + lane; \
                d_[0 * 72] = (unsigned short)(k_.x & 0xffffu); d_[1 * 72] = (unsigned short)(k_.x >> 16); d_[2 * 72] = (unsigned short)(k_.y & 0xffffu); d_[3 * 72] = (unsigned short)(k_.y >> 16); \
                d_[4 * 72] = (unsigned short)(k_.z & 0xffffu); d_[5 * 72] = (unsigned short)(k_.z >> 16); d_[6 * 72] = (unsigned short)(k_.w & 0xffffu); d_[7 * 72] = (unsigned short)(k_.w >> 16); } \
            if (tid < 128) sE[(buf_) * 128 + tid] = gcr; } while (0)
        SCAN_LOAD(0);
        SCAN_STAGE(0);
        u32x4 cw[4], cq[4], cqk[2]; float cu[4];
#pragma unroll
        for (int k = 0; k < 4; ++k) { cw[k] = wf[k]; cq[k] = qf[k]; cu[k] = bf2f(ur[k]); }
        cqk[0] = qkf[0]; cqk[1] = qkf[1];
        int pb = 0;
        for (int step = 0; step < 68; ++step) {
            const bool lat = step >= 4;
            if (step + 1 < 68) SCAN_LOAD(step + 1);
            __syncthreads();
            const float* sEg = sE + pb * 128; const float* sEd = sEg + 64; const unsigned short* sKc = sKt + pb * (128 * 72);
            f32x4 aW = (f32x4){0.f, 0.f, 0.f, 0.f}, aQ = (f32x4){0.f, 0.f, 0.f, 0.f};
#pragma unroll
            for (int kc = 0; kc < 4; ++kc) { const u32x4 y = *(const u32x4*)(sSt + (te * 16 + fr) * 136 + kc * 32 + fq * 8);
                aW = MK_MFMA(cw[kc], y, aW); if (lat) aQ = MK_MFMA(cq[kc], y, aQ); }
            const int i0 = ti * 16 + fq * 4;
            { float vn[4], vd[4];
#pragma unroll
              for (int j = 0; j < 4; ++j) { vn[j] = cu[j] - aW[j]; vd[j] = vn[j] * sEd[i0 + j]; }
              u32x2 p; p.x = pk2s(vn[0], vn[1]); p.y = pk2s(vn[2], vn[3]); *(u32x2*)(sVt + (te * 16 + fr) * 72 + i0) = p;
              p.x = pk2s(vd[0], vd[1]); p.y = pk2s(vd[2], vd[3]); *(u32x2*)(sVd + (te * 16 + fr) * 72 + i0) = p; }
            __syncthreads();
            if (lat) {
                f32x4 ao;
#pragma unroll
                for (int j = 0; j < 4; ++j) ao[j] = aQ[j] * sEg[i0 + j];
#pragma unroll
                for (int kc = 0; kc < 2; ++kc) { const u32x4 y = *(const u32x4*)(sVt + (te * 16 + fr) * 72 + kc * 32 + fq * 8); ao = MK_MFMA(cqk[kc], y, ao); }
                const int n = step - 4;
#pragma unroll
                for (int j = 0; j < 4; ++j) { const int p = n * 64 + i0 + j; const int pos = dir ? SEQ - 1 - p : p;
                    O[((size_t)dir * ML + (size_t)b * SEQ + pos) * 1024 + h * 128 + sl * 32 + te * 16 + fr] = (bf16_t)f2bf_bits(ao[j]); }
            }
            {
                const float egl = sEg[63];
                S0 = S0 * egl; S1 = S1 * egl;
#pragma unroll
                for (int kc = 0; kc < 2; ++kc) { const u32x4 x = *(const u32x4*)(sKc + (w * 16 + fr) * 72 + kc * 32 + fq * 8);
                    const u32x4 y0 = *(const u32x4*)(sVd + fr * 72 + kc * 32 + fq * 8), y1 = *(const u32x4*)(sVd + (16 + fr) * 72 + kc * 32 + fq * 8);
                    S0 = MK_MFMA(x, y0, S0); S1 = MK_MFMA(x, y1, S1); }
                u32x2 p; p.x = pk2s(S0[0], S0[1]); p.y = pk2s(S0[2], S0[3]); *(u32x2*)(sSt + fr * 136 + w * 16 + fq * 4) = p;
                p.x = pk2s(S1[0], S1[1]); p.y = pk2s(S1[2], S1[3]); *(u32x2*)(sSt + (16 + fr) * 136 + w * 16 + fq * 4) = p;
            }
            if (step + 1 < 68) {
                SCAN_STAGE(pb ^ 1);
#pragma unroll
                for (int k = 0; k < 4; ++k) { cw[k] = wf[k]; cq[k] = qf[k]; cu[k] = bf2f(ur[k]); }
                cqk[0] = qkf[0]; cqk[1] = qkf[1];
            }
            pb ^= 1;
        }
#undef SCAN_LOAD
#undef SCAN_STAGE
    }
}

__device__ __forceinline__ void phase_ogate(const bf16_t* O, bf16_t* OG, const bf16_t* PB, const float* gn, int gw, int ngw, int lane) {
    for (int r = gw; r < ML; r += ngw) {
        const bf16_t* of = O + (size_t)r * 1024 + lane * 16; const bf16_t* ob = of + (size_t)ML * 1024; bf16_t* og = OG + (size_t)r * 1024 + lane * 16; const bf16_t* zp = PB + (size_t)r * 5120 + lane * 16;
        float o[16], z[16];
#pragma unroll
        for (int hh = 0; hh < 2; ++hh) { const u32x4 a = *(const u32x4*)(of + hh * 8), bq = *(const u32x4*)(ob + hh * 8), zz = *(const u32x4*)(zp + hh * 8);
            o[hh * 8 + 0] = bflo(a.x) + bflo(bq.x); o[hh * 8 + 1] = bfhi(a.x) + bfhi(bq.x); o[hh * 8 + 2] = bflo(a.y) + bflo(bq.y); o[hh * 8 + 3] = bfhi(a.y) + bfhi(bq.y);
            o[hh * 8 + 4] = bflo(a.z) + bflo(bq.z); o[hh * 8 + 5] = bfhi(a.z) + bfhi(bq.z); o[hh * 8 + 6] = bflo(a.w) + bflo(bq.w); o[hh * 8 + 7] = bfhi(a.w) + bfhi(bq.w);
            z[hh * 8 + 0] = bflo(zz.x); z[hh * 8 + 1] = bfhi(zz.x); z[hh * 8 + 2] = bflo(zz.y); z[hh * 8 + 3] = bfhi(zz.y);
            z[hh * 8 + 4] = bflo(zz.z); z[hh * 8 + 5] = bfhi(zz.z); z[hh * 8 + 6] = bflo(zz.w); z[hh * 8 + 7] = bfhi(zz.w); }
        float ss = 0.f;
#pragma unroll
        for (int j = 0; j < 16; ++j) ss += o[j] * o[j];
        ss += __shfl_xor(ss, 1); ss += __shfl_xor(ss, 2); ss += __shfl_xor(ss, 4);
        const float rstd = rsqrtf(ss * (1.f / 128.f) + 1e-6f);
        const float* g = gn + (lane & 7) * 16;
        u32x4 w[2];
#pragma unroll
        for (int hh = 0; hh < 2; ++hh) {
            float r8[8];
#pragma unroll
            for (int j = 0; j < 8; ++j) r8[j] = o[hh * 8 + j] * rstd * g[hh * 8 + j] * silu_f(z[hh * 8 + j]);
            w[hh].x = pk2(r8[0], r8[1]); w[hh].y = pk2(r8[2], r8[3]); w[hh].z = pk2(r8[4], r8[5]); w[hh].w = pk2(r8[6], r8[7]); }
        *(u32x4*)og = w[0]; *(u32x4*)(og + 8) = w[1];
    }
}
__device__ __forceinline__ void phase_hy_tin(const bf16_t* PH, const float* cw, const float* cb, bf16_t* HYT, unsigned char* smem, int tid) {
    float* sT = (float*)smem;
    constexpr int NIT = 4 * 32 * 24;
    const int lrow = tid >> 4, lpart = tid & 15;
    const int cj = tid >> 2, cq = tid & 3;
    u32x4 xn[4]; float wn0 = 0.f, wn1 = 0.f, wn2 = 0.f, bn = 0.f;
#pragma unroll
    for (int k = 0; k < 4; ++k) xn[k] = (u32x4){0u, 0u, 0u, 0u};
#define TIN_LOAD(it_) do { const int cbk_ = (it_) % 24, sp_ = ((it_) / 24) & 31, b_ = (it_) / (24 * 32); \
        const bf16_t* p_ = PH + (size_t)(b_ * SEQ + sp_ * 128 + lrow) * 3072 + cbk_ * 128 + lpart * 8; \
        _Pragma("unroll") for (int k_ = 0; k_ < 4; ++k_) xn[k_] = *(const u32x4*)(p_ + (size_t)(32 * k_) * 3072); \
        const int col_ = cbk_ * 128 + cj; wn0 = cw[col_]; wn1 = cw[3072 + col_]; wn2 = cw[6144 + col_]; bn = cb[col_]; } while (0)
    int item = blockIdx.x;
    if (item < NIT) TIN_LOAD(item);
    for (; item < NIT; item += gridDim.x) {
        const int cbk = item % 24, sp = (item / 24) & 31, b = item / (24 * 32);
        u32x4 x[4];
#pragma unroll
        for (int k = 0; k < 4; ++k) x[k] = xn[k];
        const float w0 = wn0, w1 = wn1, w2 = wn2, bi = bn;
        if (item + (int)gridDim.x < NIT) TIN_LOAD(item + (int)gridDim.x);
#pragma unroll
        for (int k = 0; k < 4; ++k) { float* d = sT + (lrow + 32 * k) * 129 + lpart * 8;
            d[0] = bflo(x[k].x); d[1] = bfhi(x[k].x); d[2] = bflo(x[k].y); d[3] = bfhi(x[k].y); d[4] = bflo(x[k].z); d[5] = bfhi(x[k].z); d[6] = bflo(x[k].w); d[7] = bfhi(x[k].w); }
        __syncthreads();
        { const int col = cbk * 128 + cj;
#pragma unroll
          for (int k = 0; k < 4; ++k) { const int i0 = 8 * (cq + 4 * k); float y[8];
#pragma unroll
              for (int ii = 0; ii < 8; ++ii) { const int i = i0 + ii; const float xm = (i & 63) > 0 ? sT[(i - 1) * 129 + cj] : 0.f, x0 = sT[i * 129 + cj], xp = (i & 63) < 63 ? sT[(i + 1) * 129 + cj] : 0.f;
                  y[ii] = w0 * xm + w1 * x0 + w2 * xp + bi; }
              u32x4 w; w.x = pk2(y[0], y[1]); w.y = pk2(y[2], y[3]); w.z = pk2(y[4], y[5]); w.w = pk2(y[6], y[7]);
              *(u32x4*)(HYT + ((size_t)col * 4 + b) * 4096 + sp * 128 + i0) = w; } }
        __syncthreads();
    }
#undef TIN_LOAD
}
__device__ __forceinline__ int xi(int i) { return i + ((i >> 5) << 1); }
constexpr int XSZ_BYTES = (8192 + 512) * 8;
__device__ __forceinline__ f32x2 cmul(f32x2 a, f32x2 b) { return (f32x2){a.x * b.x - a.y * b.y, a.x * b.y + a.y * b.x}; }
__device__ __forceinline__ f32x2 twid(const f32x2* TW, int k) { f32x2 w = TW[k & 2047]; if (k & 2048) w = (f32x2){w.y, -w.x}; return w; }
__device__ __forceinline__ void tw_init(f32x2* TW, int tid) {
    for (int k = tid; k < 2048; k += 512) { float s, c; sincospif((float)k * (1.f / 4096.f), &s, &c); TW[k] = (f32x2){c, -s}; }
}
template <int M, bool INV> __device__ __forceinline__ f32x2 cmul8(f32x2 d) {
    constexpr float C8[8] = {1.f, 0.9238795325112867f, 0.7071067811865476f, 0.3826834323650898f, 0.f, -0.3826834323650898f, -0.7071067811865476f, -0.9238795325112867f};
    constexpr float S8[8] = {0.f, 0.3826834323650898f, 0.7071067811865476f, 0.9238795325112867f, 1.f, 0.9238795325112867f, 0.7071067811865476f, 0.3826834323650898f};
    constexpr float r = 0.7071067811865476f;
    if constexpr (M == 0) return d;
    else if constexpr (M == 4) return INV ? (f32x2){-d.y, d.x} : (f32x2){d.y, -d.x};
    else if constexpr (M == 2) return INV ? (f32x2){(d.x - d.y) * r, (d.x + d.y) * r} : (f32x2){(d.x + d.y) * r, (d.y - d.x) * r};
    else if constexpr (M == 6) return INV ? (f32x2){-(d.x + d.y) * r, (d.x - d.y) * r} : (f32x2){(d.y - d.x) * r, -(d.x + d.y) * r};
    else return cmul(d, (f32x2){C8[M], INV ? S8[M] : -S8[M]});
}
__device__ __forceinline__ f32x2 twid8(const f32x2* TW, int k) { f32x2 w = twid(TW, k & 4095); if (k & 4096) w = (f32x2){-w.x, -w.y}; return w; }
template <int K, bool INV> __device__ __forceinline__ void fft16_stage(f32x2 (&x)[16], const f32x2 tg) {
#define FFT16_BF(E_) do { if constexpr (((E_) & (1 << K)) == 0) { constexpr int m_ = ((E_) & ((1 << K) - 1)) << (3 - K); \
        if constexpr (!INV) { const f32x2 a_ = x[E_], b_ = x[(E_) | (1 << K)]; x[E_] = a_ + b_; x[(E_) | (1 << K)] = cmul(cmul8<m_, false>(a_ - b_), tg); } \
        else { const f32x2 a_ = x[E_], b_ = cmul8<m_, true>(cmul(x[(E_) | (1 << K)], tg)); x[E_] = a_ + b_; x[(E_) | (1 << K)] = a_ - b_; } } } while (0)
    FFT16_BF(0); FFT16_BF(1); FFT16_BF(2); FFT16_BF(3); FFT16_BF(4); FFT16_BF(5); FFT16_BF(6); FFT16_BF(7);
    FFT16_BF(8); FFT16_BF(9); FFT16_BF(10); FFT16_BF(11); FFT16_BF(12); FFT16_BF(13); FFT16_BF(14); FFT16_BF(15);
#undef FFT16_BF
}
template <int P> __device__ __forceinline__ void fft16_fwd(f32x2* X, const f32x2* TW, int tid) {
    const int lo = tid & ((1 << P) - 1), base = ((tid >> P) << (P + 4)) | lo;
    f32x2 x[16];
#pragma unroll
    for (int e = 0; e < 16; ++e) x[e] = X[xi(base | (e << P))];
    const f32x2 t3 = twid(TW, lo << (9 - P)), t2 = cmul(t3, t3), t1 = cmul(t2, t2), t0 = cmul(t1, t1);
    fft16_stage<3, false>(x, t3); fft16_stage<2, false>(x, t2); fft16_stage<1, false>(x, t1); fft16_stage<0, false>(x, t0);
#pragma unroll
    for (int e = 0; e < 16; ++e) X[xi(base | (e << P))] = x[e];
}
template <int P> __device__ __forceinline__ void fft16_inv(f32x2* X, const f32x2* TW, int tid) {
    const int lo = tid & ((1 << P) - 1), base = ((tid >> P) << (P + 4)) | lo;
    f32x2 x[16];
#pragma unroll
    for (int e = 0; e < 16; ++e) x[e] = X[xi(base | (e << P))];
    const f32x2 t3 = twid(TW, lo << (9 - P)), t2 = cmul(t3, t3), t1 = cmul(t2, t2), t0 = cmul(t1, t1);
    fft16_stage<0, true>(x, (f32x2){t0.x, -t0.y}); fft16_stage<1, true>(x, (f32x2){t1.x, -t1.y}); fft16_stage<2, true>(x, (f32x2){t2.x, -t2.y}); fft16_stage<3, true>(x, (f32x2){t3.x, -t3.y});
#pragma unroll
    for (int e = 0; e < 16; ++e) X[xi(base | (e << P))] = x[e];
}
__device__ __forceinline__ void fft_fwd3(f32x2* X, const f32x2* TW, int tid) {
    fft16_fwd<9>(X, TW, tid); __syncthreads(); fft16_fwd<5>(X, TW, tid); __syncthreads(); fft16_fwd<1>(X, TW, tid); __syncthreads();
}
__device__ __forceinline__ void fft_inv3(f32x2* X, const f32x2* TW, int tid) {
    fft16_inv<1>(X, TW, tid); __syncthreads(); fft16_inv<5>(X, TW, tid); __syncthreads(); fft16_inv<9>(X, TW, tid); __syncthreads();
}
__device__ __forceinline__ void fft_mid(f32x2* X, const f32x4 (&kk)[8], int tid) {
#pragma unroll
    for (int u = 0; u < 8; ++u) { const int i = 2 * (tid + 512 * u);
        const f32x4 v = *(const f32x4*)(X + xi(i));
        const f32x2 a = cmul((f32x2){v.x + v.z, v.y + v.w}, (f32x2){kk[u].x, kk[u].y}), b = cmul((f32x2){v.x - v.z, v.y - v.w}, (f32x2){kk[u].z, kk[u].w});
        *(f32x4*)(X + xi(i)) = (f32x4){a.x + b.x, a.y + b.y, a.x - b.x, a.y - b.y}; }
    __syncthreads();
}
#define FFT_KLOAD(kk_, kf_) do { _Pragma("unroll") for (int u_ = 0; u_ < 8; ++u_) kk_[u_] = *(const f32x4*)((kf_) + 2 * (tid + 512 * u_)); } while (0)
__device__ __forceinline__ void split8(const f32x4 a, const f32x4 b, u32x4& hi, u32x4& lo) {
    hi.x = pk2(a.x, a.y); hi.y = pk2(a.z, a.w); hi.z = pk2(b.x, b.y); hi.w = pk2(b.z, b.w);
    lo.x = pk2(a.x - bflo(hi.x), a.y - bfhi(hi.x)); lo.y = pk2(a.z - bflo(hi.y), a.w - bfhi(hi.y));
    lo.z = pk2(b.x - bflo(hi.z), b.y - bfhi(hi.z)); lo.w = pk2(b.z - bflo(hi.w), b.w - bfhi(hi.w));
}
__device__ __forceinline__ void phase_hy_filt(const float* H2, const float* w3, f32x2* KFS, unsigned char* smem, int tid) {
    f32x2* X = (f32x2*)smem; f32x2* TW = (f32x2*)(smem + XSZ_BYTES); float* sRed = (float*)(smem + XSZ_BYTES + 16384);
    const int lane = tid & 63, wv = tid >> 6, fr = lane & 15, fq = lane >> 4;
    tw_init(TW, tid);
    float* KF = (float*)KFS;
    for (int cg = blockIdx.x; cg < 256; cg += gridDim.x) {
        const int c0 = cg * 4;
        const int ch = fr >> 2, ord = (fr >> 1) & 1, dr = fr & 1, c = c0 + ch;
        const int wcol = ord * 2048 + dr * 1024 + c;
        u32x4 yh[2], yl[2];
#pragma unroll
        for (int kc = 0; kc < 2; ++kc) { float wv8[8];
#pragma unroll
            for (int e = 0; e < 8; ++e) wv8[e] = w3[(size_t)(kc * 32 + fq * 8 + e) * 4096 + wcol];
            split8((f32x4){wv8[0], wv8[1], wv8[2], wv8[3]}, (f32x4){wv8[4], wv8[5], wv8[6], wv8[7]}, yh[kc], yl[kc]); }
        const float a0 = -3.0701134573253945f, a1 = -15.350567286626973f;
        const float delta = fabsf(a0 + (float)c * ((a1 - a0) / 1023.f));
        float* kdst = KF + (size_t)(ord * 1024 + c) * 16384;
        float sabs = 0.f;
#pragma unroll 1
        for (int mt = wv; mt < 256; mt += 8) {
            const float* hp = H2 + (size_t)(mt * 16 + fr) * 64 + fq * 8;
            const f32x4 h0 = *(const f32x4*)hp, h1 = *(const f32x4*)(hp + 4), h2 = *(const f32x4*)(hp + 32), h3 = *(const f32x4*)(hp + 36);
            u32x4 xh0, xl0, xh1, xl1; split8(h0, h1, xh0, xl0); split8(h2, h3, xh1, xl1);
            f32x4 acc = (f32x4){0.f, 0.f, 0.f, 0.f};
            acc = MK_MFMA(xh0, yh[0], acc); acc = MK_MFMA(xh0, yl[0], acc); acc = MK_MFMA(xl0, yh[0], acc);
            acc = MK_MFMA(xh1, yh[1], acc); acc = MK_MFMA(xh1, yl[1], acc); acc = MK_MFMA(xl1, yh[1], acc);
            const int t0 = mt * 16 + fq * 4; float v[4];
#pragma unroll
            for (int jj = 0; jj < 4; ++jj) { v[jj] = acc[jj] * expf(-((float)(t0 + jj) * (1.f / 4096.f)) * delta); sabs += fabsf(v[jj]); }
            if (dr == 0) *(f32x4*)(kdst + t0) = (f32x4){v[0], v[1], v[2], v[3]};
            else {
#pragma unroll
                for (int jj = 0; jj < 4; ++jj) if (t0 + jj > 0) kdst[8192 - t0 - jj] = v[jj]; }
        }
        sabs += __shfl_xor(sabs, 16); sabs += __shfl_xor(sabs, 32);
        __syncthreads();
        if (lane < 16) sRed[wv * 16 + lane] = sabs;
        if (tid < 8) KF[(size_t)((tid & 1) * 1024 + c0 + (tid >> 1)) * 16384 + 4096] = 0.f;
        asm volatile("s_waitcnt vmcnt(0)" ::: "memory");
        __syncthreads();
        float kv0[16], kv1[16];
#pragma unroll 1
        for (int chn = 0; chn < 4; ++chn) {
            const int n0 = chn * 4;
            float nr0 = 0.f, nr1 = 0.f;
#pragma unroll
            for (int w = 0; w < 8; ++w) { nr0 += sRed[w * 16 + n0] + sRed[w * 16 + n0 + 1]; nr1 += sRed[w * 16 + n0 + 2] + sRed[w * 16 + n0 + 3]; }
            float* kb0 = KF + (size_t)(c0 + chn) * 16384; float* kb1 = KF + (size_t)(1024 + c0 + chn) * 16384;
            if (chn == 0) {
#pragma unroll
                for (int u = 0; u < 16; ++u) { kv0[u] = __hip_atomic_load(kb0 + tid + 512 * u, __ATOMIC_RELAXED, __HIP_MEMORY_SCOPE_AGENT); kv1[u] = __hip_atomic_load(kb1 + tid + 512 * u, __ATOMIC_RELAXED, __HIP_MEMORY_SCOPE_AGENT); } }
#pragma unroll
            for (int u = 0; u < 16; ++u) X[xi(tid + 512 * u)] = (f32x2){kv0[u], kv1[u]};
            if (chn < 3) {
#pragma unroll
                for (int u = 0; u < 16; ++u) { kv0[u] = __hip_atomic_load(kb0 + 16384 + tid + 512 * u, __ATOMIC_RELAXED, __HIP_MEMORY_SCOPE_AGENT); kv1[u] = __hip_atomic_load(kb1 + 16384 + tid + 512 * u, __ATOMIC_RELAXED, __HIP_MEMORY_SCOPE_AGENT); } }
            __syncthreads();
            fft_fwd3(X, TW, tid);
#pragma unroll
            for (int u = 0; u < 8; ++u) { const int i = 2 * (tid + 512 * u); const f32x4 vv = *(const f32x4*)(X + xi(i));
                *(f32x4*)(X + xi(i)) = (f32x4){vv.x + vv.z, vv.y + vv.w, vv.x - vv.z, vv.y - vv.w}; }
            __syncthreads();
            const float sc0 = 0.5f / (nr0 * 8192.f), sc1 = 0.5f / (nr1 * 8192.f);
            f32x2* d0 = (f32x2*)kb0; f32x2* d1 = (f32x2*)kb1;
#pragma unroll
            for (int u = 0; u < 16; ++u) { const int pidx = tid + 512 * u;
                const int f = (int)(__brev((unsigned)pidx) >> 19), fp = (8192 - f) & 8191, pp = (int)(__brev((unsigned)fp) >> 19);
                const f32x2 Z = X[xi(pidx)], Zp = X[xi(pp)];
                d0[pidx] = (f32x2){(Z.x + Zp.x) * sc0, (Z.y - Zp.y) * sc0};
                d1[pidx] = (f32x2){(Z.y + Zp.y) * sc1, (Zp.x - Z.x) * sc1}; }
            __syncthreads();
        }
    }
}
__device__ __forceinline__ void unpack8(const u32x4 x, float* d) { d[0] = bflo(x.x); d[1] = bfhi(x.x); d[2] = bflo(x.y); d[3] = bfhi(x.y); d[4] = bflo(x.z); d[5] = bfhi(x.z); d[6] = bflo(x.w); d[7] = bfhi(x.w); }
__device__ __forceinline__ void conv8(const u32x4 x, float w0, float w1, float w2, float bi, float* y) {
    const int l8 = threadIdx.x & 7;
    const unsigned up = __shfl_up(x.w, 1), dn = __shfl_down(x.x, 1);
    const float left = l8 == 0 ? 0.f : bfhi(up), right = l8 == 7 ? 0.f : bflo(dn);
    float v[8]; unpack8(x, v);
    y[0] = w0 * left + w1 * v[0] + w2 * v[1] + bi;
#pragma unroll
    for (int e = 1; e < 7; ++e) y[e] = w0 * v[e - 1] + w1 * v[e] + w2 * v[e + 1] + bi;
    y[7] = w0 * v[6] + w1 * v[7] + w2 * right + bi;
}
__device__ __forceinline__ void phase_hy_main(const bf16_t* HYT, bf16_t* Z2T, const f32x2* KFS, const float* hy_bias, const float* cw, const float* cbias, unsigned char* smem, int tid, int vb) {
    f32x2* X = (f32x2*)smem; f32x2* TW = (f32x2*)(smem + XSZ_BYTES); f32x2* Z1 = (f32x2*)(smem + XSZ_BYTES + 16384);
    tw_init(TW, tid);
    const int t0 = tid * 8;
    u32x4 nv0, nv1, nx1a, nx1b, nx2a, nx2b;
    nv0 = nv1 = nx1a = nx1b = nx2a = nx2b = (u32x4){0u, 0u, 0u, 0u};
#define HYM_LOAD(it_) do { const int c_ = (it_) >> 1, b0_ = ((it_) & 1) * 2; \
        const bf16_t* v_ = HYT + ((size_t)c_ * 4 + b0_) * 4096 + t0; const bf16_t* x1_ = HYT + ((size_t)(1024 + c_) * 4 + b0_) * 4096 + t0; const bf16_t* x2_ = HYT + ((size_t)(2048 + c_) * 4 + b0_) * 4096 + t0; \
        nv0 = *(const u32x4*)v_; nv1 = *(const u32x4*)(v_ + 4096); nx1a = *(const u32x4*)x1_; nx1b = *(const u32x4*)(x1_ + 4096); nx2a = *(const u32x4*)x2_; nx2b = *(const u32x4*)(x2_ + 4096); } while (0)
    int item = vb;
    if (item < 2048) HYM_LOAD(item);
    for (; item < 2048; item += gridDim.x) {
        const int c = item >> 1, b0 = (item & 1) * 2;
        bf16_t* z0 = Z2T + ((size_t)c * 4 + b0) * 4096 + t0;
        const float bias1 = hy_bias[c], bias2 = hy_bias[1024 + c];
        const u32x4 rx1a = nx1a, rx1b = nx1b, rx2a = nx2a, rx2b = nx2b;
        const float cv0 = cw[c], cv1 = cw[3072 + c], cv2 = cw[6144 + c], cvb = cbias[c];
        const float c10 = cw[1024 + c], c11 = cw[3072 + 1024 + c], c12 = cw[6144 + 1024 + c], c1b = cbias[1024 + c];
        const float c20 = cw[2048 + c], c21 = cw[3072 + 2048 + c], c22 = cw[6144 + 2048 + c], c2b = cbias[2048 + c];
        float va[8], vb[8];
        conv8(nv0, cv0, cv1, cv2, cvb, va); conv8(nv1, cv0, cv1, cv2, cvb, vb);
        __syncthreads();
#pragma unroll
        for (int e = 0; e < 8; ++e) { X[xi(t0 + e)] = (f32x2){va[e], vb[e]}; X[xi(4096 + t0 + e)] = (f32x2){0.f, 0.f}; }
        __syncthreads();
        { f32x4 kk[8]; FFT_KLOAD(kk, KFS + (size_t)c * 8192);
          fft_fwd3(X, TW, tid);
          fft_mid(X, kk, tid); }
        fft_inv3(X, TW, tid);
        { float xa[8], xb[8]; conv8(rx1a, c10, c11, c12, c1b, xa); conv8(rx1b, c10, c11, c12, c1b, xb);
#pragma unroll
          for (int e = 0; e < 8; ++e) { const f32x2 y = X[xi(t0 + e)]; const f32x2 z = (f32x2){xa[e] * (y.x + va[e] * bias1), xb[e] * (y.y + vb[e] * bias1)};
              Z1[t0 + e] = z; X[xi(t0 + e)] = z; X[xi(4096 + t0 + e)] = (f32x2){0.f, 0.f}; } }
        if (item + (int)gridDim.x < 2048) HYM_LOAD(item + (int)gridDim.x);
        __syncthreads();
        { f32x4 kk[8]; FFT_KLOAD(kk, KFS + (size_t)(1024 + c) * 8192);
          fft_fwd3(X, TW, tid);
          fft_mid(X, kk, tid); }
        fft_inv3(X, TW, tid);
        { float xa[8], xb[8], ra[8], rb[8]; conv8(rx2a, c20, c21, c22, c2b, xa); conv8(rx2b, c20, c21, c22, c2b, xb);
#pragma unroll
          for (int e = 0; e < 8; ++e) { const f32x2 y = X[xi(t0 + e)], z = Z1[t0 + e]; ra[e] = xa[e] * (y.x + z.x * bias2); rb[e] = xb[e] * (y.y + z.y * bias2); }
          u32x4 w; w.x = pk2(ra[0], ra[1]); w.y = pk2(ra[2], ra[3]); w.z = pk2(ra[4], ra[5]); w.w = pk2(ra[6], ra[7]); *(u32x4*)z0 = w;
          w.x = pk2(rb[0], rb[1]); w.y = pk2(rb[2], rb[3]); w.z = pk2(rb[4], rb[5]); w.w = pk2(rb[6], rb[7]); *(u32x4*)(z0 + 4096) = w; }
    }
#undef HYM_LOAD
}
__device__ __forceinline__ void phase_hy_tout(const bf16_t* HYT, bf16_t* Z2, unsigned char* smem, int tid) {
    unsigned short* sT = (unsigned short*)smem;
    constexpr int NIT = 4 * 64 * 16;
    const int j = tid >> 3, part = tid & 7;
    u32x4 xn = (u32x4){0u, 0u, 0u, 0u};
#define TOUT_LOAD(it_) do { const int cbk_ = (it_) & 15, tb_ = ((it_) >> 4) & 63, b_ = (it_) >> 10; \
        xn = *(const u32x4*)(HYT + ((size_t)(cbk_ * 64 + j) * 4 + b_) * 4096 + tb_ * 64 + part * 8); } while (0)
    int item = blockIdx.x;
    if (item < NIT) TOUT_LOAD(item);
    for (; item < NIT; item += gridDim.x) {
        const int cbk = item & 15, tb = (item >> 4) & 63, b = item >> 10;
        const u32x4 x = xn;
        if (item + (int)gridDim.x < NIT) TOUT_LOAD(item + (int)gridDim.x);
        *(u32x4*)(sT + j * 72 + part * 8) = x;
        __syncthreads();
        { const int i = tid >> 3; unsigned short r[8];
#pragma unroll
          for (int jj = 0; jj < 8; ++jj) r[jj] = sT[(part * 8 + jj) * 72 + i];
          u32x4 w; w.x = r[0] | ((unsigned)r[1] << 16); w.y = r[2] | ((unsigned)r[3] << 16); w.z = r[4] | ((unsigned)r[5] << 16); w.w = r[6] | ((unsigned)r[7] << 16);
          *(u32x4*)(Z2 + (size_t)(b * SEQ + tb * 64 + i) * 1024 + cbk * 64 + part * 8) = w; }
        __syncthreads();
    }
#undef TOUT_LOAD
}

constexpr int N_PHASES = 18;
__global__ void __launch_bounds__(512, 2) mk_fwd(Args a) {
    extern __shared__ __attribute__((aligned(16))) unsigned char smem[];
    const int tid = threadIdx.x, lane = tid & 63, wv = tid >> 6;
    const int G = gridDim.x, bid = blockIdx.x;
    const int gw = bid * 8 + wv, ngw = G * 8, gtid = bid * 512 + tid, ngt = G * 512;
    unsigned char* ws = a.ws;
    const float* x = a.in[0]; const float* ctx = a.in[2]; const float* norm_g = a.in[6];
    float* out = a.out;
    float* MOD = (float*)(ws + OFF_MOD); float* H2 = (float*)(ws + OFF_H2); float* HC = (float*)(ws + OFF_HC); float* ABF = (float*)(ws + OFF_ABF);
    float* Gd = (float*)(ws + OFF_G); float* BETA = (float*)(ws + OFF_BETA);
    bf16_t* XN = (bf16_t*)(ws + OFF_XN); bf16_t* WA = (bf16_t*)(ws + OFF_WA); bf16_t* WAD = (bf16_t*)(ws + OFF_WA_D); bf16_t* WB = (bf16_t*)(ws + OFF_WB);
    bf16_t* ACT = (bf16_t*)(ws + OFF_ACT); bf16_t* PH = (bf16_t*)(ws + OFF_PH); bf16_t* PQKV = (bf16_t*)(ws + OFF_PQKV); bf16_t* PB = (bf16_t*)(ws + OFF_PB);
    bf16_t* Ob = (bf16_t*)(ws + OFF_O); bf16_t* OG = (bf16_t*)(ws + OFF_OG); bf16_t* Z2T = (bf16_t*)(ws + OFF_Z2T);
    bf16_t* Ub = (bf16_t*)(ws + OFF_U); bf16_t* Wb = (bf16_t*)(ws + OFF_W); bf16_t* QKb = (bf16_t*)(ws + OFF_QK); float* GC = (float*)(ws + OFF_GC);
    f32x2* KFS = (f32x2*)(ws + OFF_KFS); bf16_t* HYT = (bf16_t*)(ws + OFF_HYT); bf16_t* Z2 = (bf16_t*)(ws + OFF_Z2); float* TMP = (float*)(ws + OFF_TMP);
    bf16_t* WHY = (bf16_t*)(ws + OFF_WHY); bf16_t* WGD = (bf16_t*)(ws + OFF_WGD); bf16_t* WO = (bf16_t*)(ws + OFF_WO);
    PG8_LAS unsigned char* lds = (PG8_LAS unsigned char*)smem;
    const int lo = a.ph_lo, hi = a.ph_hi;
    const int vcu = (G % 8 == 0) ? (bid % 8) * (G / 8) + bid / 8 : bid;
#ifndef PH_MASK
#define PH_MASK 0x3ffff
#endif
#define IN(k) (((PH_MASK >> (k)) & 1) && lo <= (k) && (k) < hi)
    XcdBarrier xb; xb.bar = (unsigned*)(ws + OFF_BAR); xb.x = 0; xb.st = (volatile LAS unsigned*)(lds + LDS_BYTES - 16);
    if (hi - lo > 1) { if (tid < 4) xb.st[tid] = 0u; __syncthreads(); xb = xcd_barrier_post((unsigned*)(ws + OFF_BAR), (volatile LAS unsigned*)(lds + LDS_BYTES - 16)); }
#define SEAM(k) do { if ((k) + 1 < hi) { if ((k) == 0) cg::this_grid().sync(); else xcd_barrier(xb); } } while (0)

    if (IN(0)) {
        phase_mod(a.in[1], a.in[3], a.in[4], a.in[5], MOD, smem, tid);
        phase_h2(a.in[14], a.in[15], a.in[16], a.in[17], a.in[19], H2, gw, ngw, lane);
        __syncthreads();
        float* scr = (float*)(smem + wv * CONV_SCR);
        constexpr int I1 = 32 * 176;
        for (int it = gw; it < I1; it += ngw) conv_matrix(a.in[7], D, 2 * FF, WA, 2 * FF, 1, it, scr, lane);
        SEAM(0);
    }
    if (IN(1)) {
        for (int r = gw; r < MT; r += ngw) { const bool lat = r < ML; const int bm = lat ? (r >> 12) : 4;
            const float* src = lat ? x + (size_t)r * D : ctx + (size_t)(r - ML) * D; const float* m = MOD + (size_t)bm * NMOD;
            norm_ada_row(src, norm_g, m, m + D, XN + (size_t)r * D, lane); }
        SEAM(1);
    }
    if (IN(2)) {
        const bool conv_first = ((bid >> 3) & 1) == 0;
#define CONV_P2() do { float* scr = (float*)(smem + wv * CONV_SCR); constexpr int I2 = 88 * 32, I3 = 32 * 180; __syncthreads(); \
            for (int it = gw; it < I2 + I3; it += ngw) { if (it < I2) conv_matrix(a.in[8], FF, D, WAD, D, 0, it, scr, lane); else conv_matrix(a.in[11], D, 11296, WB, NIN, 2, it - I2, scr, lane); } \
            __syncthreads(); } while (0)
        if (conv_first) CONV_P2();
        { pg8::Gemm g{XN, WA, ML, 2 * FF, D, D, 0}; pg8::StaticOrder S; S.init(ML, 2 * FF, G, bid);
          EpiSwiglu E{ACT, FF};
          pg8::gemm_phase<EpiSwiglu, pg8::StaticOrder>(lds, g, S, E, nullptr); }
        { pg8::Gemm g{XN + (size_t)ML * D, WA, MC, 2 * FF, D, D, 0}; pg8::StaticOrder S; S.init(MC, 2 * FF, G, bid);
          EpiSwiglu E{ACT + (size_t)ML * FF, FF};
          pg8::gemm_phase<EpiSwiglu, pg8::StaticOrder>(lds, g, S, E, nullptr); }
        if (!conv_first) CONV_P2();
#undef CONV_P2
        SEAM(2);
    }
    if (IN(3)) {
        { pg8::Gemm g{ACT, WAD, ML, D, FF, FF, 0}; pg8::StaticOrder S; S.init(ML, D, G, bid);
          EpiResid E{x, ctx, out, HC, MOD + 2 * D, 0.5f};
          pg8::gemm_phase<EpiResid, pg8::StaticOrder>(lds, g, S, E, nullptr); }
        { pg8::Gemm g{ACT + (size_t)ML * FF, WAD, MC, D, FF / 4, FF, (size_t)(FF / 4) * 2}; CtxSplitOrder S{G, bid};
          EpiCtxPart E{(float*)(ws + OFF_PB), MOD + (size_t)4 * NMOD + 2 * D, 0.5f};
          pg8::gemm_phase<EpiCtxPart, CtxSplitOrder>(lds, g, S, E, nullptr); }
        SEAM(3);
    }
    if (IN(4)) {
        for (int r = gw; r < MT; r += ngw) { const bool lat = r < ML; const int bm = lat ? (r >> 12) : 4;
            const float* m = MOD + (size_t)bm * NMOD;
            if (lat) norm_ada_row(out + (size_t)r * D, norm_g + D, m + 3 * D, m + 4 * D, XN + (size_t)r * D, lane);
            else norm_ada_row_ctx(ctx + (size_t)(r - ML) * D, (const float*)(ws + OFF_PB) + (size_t)(r - ML) * D, norm_g + D, m + 3 * D, m + 4 * D, XN + (size_t)r * D, lane); }
        SEAM(4);
    }
    if (IN(5)) {
        pg8::Gemm g{XN, WB, MT, NIN, D, D, 0}; WinOrder S; S.init(ML, NIN, G, bid);
        EpiWin E{PH, PQKV, PB, ABF};
        pg8::gemm_phase<EpiWin, WinOrder>(lds, g, S, E, nullptr);
        SEAM(5);
    }
    if (IN(6)) {
        phase_gbeta(ABF, a.in[23], a.in[24], Gd, BETA, gtid, ngt);
        phase_gdn_conv(PQKV, a.in[22], smem, tid);
        SEAM(6);
    }
    if (IN(7)) {
        phase_gdn_prep(PQKV, Gd, BETA, Ub, Wb, QKb, GC, smem, tid);
        SEAM(7);
    }
    if (IN(8)) {
        phase_scan(PQKV, Ub, Wb, QKb, GC, Ob, smem, tid, vcu);
        SEAM(8);
    }
    if (IN(9)) {
        const bool mem_first = ((bid >> 3) & 1) == 0;
        if (mem_first && (a.sub & 1)) phase_ogate(Ob, OG, PB, a.in[25], gw, ngw, lane);
        float* scr = (float*)(smem + wv * CONV_SCR);
        constexpr int I1 = 16 * 32, I2 = 16 * 32, I3 = 32 * 32;
        if (mem_first && (a.sub & 8)) { for (int it = gw; it < I1 + I2 + I3; it += ngw) {
            if (it < I1) conv_matrix(a.in[21], 1024, D, WHY, D, 0, it, scr, lane);
            else if (it < I1 + I2) conv_matrix(a.in[26], 1024, D, WGD, D, 0, it - I1, scr, lane);
            else conv_matrix(a.in[27], D, D, WO, D, 0, it - I1 - I2, scr, lane); } }
        __syncthreads();
        if (a.sub & 4) phase_hy_filt(H2, a.in[18], KFS, smem, tid);
        __syncthreads();
        if (!mem_first && (a.sub & 8)) { for (int it = gw; it < I1 + I2 + I3; it += ngw) {
            if (it < I1) conv_matrix(a.in[21], 1024, D, WHY, D, 0, it, scr, lane);
            else if (it < I1 + I2) conv_matrix(a.in[26], 1024, D, WGD, D, 0, it - I1, scr, lane);
            else conv_matrix(a.in[27], D, D, WO, D, 0, it - I1 - I2, scr, lane); } }
        if (!mem_first && (a.sub & 1)) phase_ogate(Ob, OG, PB, a.in[25], gw, ngw, lane);
        SEAM(9);
    }
    if (IN(10)) {
        phase_hy_main(HYT, Z2T, KFS, a.in[20], a.in[12], a.in[13], smem, tid, vcu);
        SEAM(10);
    }
    if (IN(11)) {
        phase_hy_tout(Z2T, Z2, smem, tid);
        SEAM(11);
    }
    if (IN(12)) {
        const bool conv_first = ((bid >> 3) & 1) == 0;
#define CONV_P12() do { float* scr = (float*)(smem + wv * CONV_SCR); constexpr int I1 = 32 * 176, I2 = 88 * 32; __syncthreads(); \
            for (int it = gw; it < I1 + I2; it += ngw) { if (it < I1) conv_matrix(a.in[9], D, 2 * FF, WA, 2 * FF, 1, it, scr, lane); else conv_matrix(a.in[10], FF, D, WAD, D, 0, it - I1, scr, lane); } \
            __syncthreads(); } while (0)
        if (conv_first) CONV_P12();
        { pg8::Gemm g{Z2, WHY, ML, D, 1024, 1024, 0}; pg8::StaticOrder S; S.init(ML, D, G, bid);
          EpiMerge<0> E{PB + 1024, TMP, nullptr};
          pg8::gemm_phase<EpiMerge<0>, pg8::StaticOrder>(lds, g, S, E, nullptr); }
        { pg8::Gemm g{OG, WGD, ML, D, 1024, 1024, 0}; pg8::StaticOrder S; S.init(ML, D, G, bid);
          EpiMerge<1> E{PB + 1024 + 2048, TMP, XN};
          pg8::gemm_phase<EpiMerge<1>, pg8::StaticOrder>(lds, g, S, E, nullptr); }
        if (!conv_first) CONV_P12();
#undef CONV_P12
        SEAM(12);
    }
    if (IN(13)) {
        pg8::Gemm g{XN, WO, ML, D, D, D, 0}; pg8::StaticOrder S; S.init(ML, D, G, bid);
        EpiResid E{out, out, out, out, MOD + 5 * D, 1.0f};
        pg8::gemm_phase<EpiResid, pg8::StaticOrder>(lds, g, S, E, nullptr);
        SEAM(13);
    }
    if (IN(14)) {
        for (int r = gw; r < ML; r += ngw) { const float* m = MOD + (size_t)(r >> 12) * NMOD;
            norm_ada_row(out + (size_t)r * D, norm_g + 2 * D, m + 6 * D, m + 7 * D, XN + (size_t)r * D, lane); }
        SEAM(14);
    }
    if (IN(15)) {
        pg8::Gemm g{XN, WA, ML, 2 * FF, D, D, 0}; pg8::StaticOrder S; S.init(ML, 2 * FF, G, bid);
        EpiSwiglu E{ACT, FF};
        pg8::gemm_phase<EpiSwiglu, pg8::StaticOrder>(lds, g, S, E, nullptr);
        SEAM(15);
    }
    if (IN(16)) {
        pg8::Gemm g{ACT, WAD, ML, D, FF, FF, 0}; pg8::StaticOrder S; S.init(ML, D, G, bid);
        EpiResid E{out, out, out, out, MOD + 8 * D, 0.5f};
        pg8::gemm_phase<EpiResid, pg8::StaticOrder>(lds, g, S, E, nullptr);
        SEAM(16);
    }
    if (IN(17)) {
        for (int r = gw; r < ML; r += ngw) final_norm_row(out + (size_t)r * D, a.in[28], lane);
    }
#undef IN
#undef SEAM
}
}

extern "C" void kernel_launch(void* const* d_in, const int* in_sizes, int n_in, void* d_out, int out_size, void* d_ws, size_t ws_size, hipStream_t stream) {
    static int grid = 0;
    if (grid == 0) {
        int dev = 0, cus = 0, per_cu = 0;
        if (hipGetDevice(&dev) != hipSuccess || hipDeviceGetAttribute(&cus, hipDeviceAttributeMultiprocessorCount, dev) != hipSuccess || cus <= 0) { fprintf(stderr, "kernel_launch: device query failed\n"); grid = -1; return; }
        if (hipFuncSetAttribute((const void*)mk::mk_fwd, hipFuncAttributeMaxDynamicSharedMemorySize, mk::LDS_BYTES) != hipSuccess) { fprintf(stderr, "kernel_launch: hipFuncSetAttribute failed\n"); grid = -1; return; }
        if (hipOccupancyMaxActiveBlocksPerMultiprocessor(&per_cu, (const void*)mk::mk_fwd, 512, mk::LDS_BYTES) != hipSuccess || per_cu < 1) { fprintf(stderr, "kernel_launch: occupancy query gave %d\n", per_cu); per_cu = 1; }
        (void)hipGetLastError();
        grid = cus;
    }
    if (grid < 0) return;
    if (n_in != 29 || ws_size < mk::WS_END) { fprintf(stderr, "kernel_launch: n_in %d ws %zu (need %zu)\n", n_in, ws_size, (size_t)mk::WS_END); return; }
    mk::Args a{};
    for (int i = 0; i < 29; ++i) a.in[i] = (const float*)d_in[i];
    a.out = (float*)d_out; a.ws = (unsigned char*)d_ws; a.sub = 15;
#if MK_MULTI
#ifndef REPEAT_MASK
#define REPEAT_MASK 0
#endif
    for (int ph = 0; ph < mk::N_PHASES; ++ph) { a.ph_lo = ph; a.ph_hi = ph + 1;
        const int reps = ((REPEAT_MASK >> ph) & 1) ? 2 : 1;
        for (int r = 0; r < reps; ++r) {
#ifdef REPEAT_SUB
            a.sub = (r == 0) ? 15 : REPEAT_SUB;
#endif
            hipLaunchKernelGGL(mk::mk_fwd, dim3(grid), dim3(512), mk::LDS_BYTES, stream, a); } }
#else
    a.ph_lo = 0; a.ph_hi = mk::N_PHASES;
    if (hipMemsetAsync((char*)d_ws + mk::OFF_BAR, 0, (size_t)XCD_BAR_WORDS * 4, stream) != hipSuccess) { fprintf(stderr, "kernel_launch: memset of the barrier words failed\n"); return; }
    void* args[] = {&a};
    hipError_t e = hipLaunchCooperativeKernel((const void*)mk::mk_fwd, dim3(grid), dim3(512), args, mk::LDS_BYTES, stream);
    if (e != hipSuccess) fprintf(stderr, "kernel_launch: cooperative launch failed: %s (grid %d)\n", hipGetErrorString(e), grid);
#endif
}
```
